# Optimizing an MI355X kernel written in HIP

```python
import jax, jax.numpy as jnp
from jax import lax
import numpy as np

D_MODEL = 1024
BATCH = 16
SEQ = 4096
DEPTH = 2
DEC_BATCH = 8
DEC_SEQ = 32
PAST_LEN = 1024

CHUNK = 64
D_MIX = D_MODEL
W_GROUP = D_MIX // 4
POOL_WINDOWS = (2, 4, 8, 16)
N_POOL_GROUPS = len(POOL_WINDOWS)
POOL_GC = W_GROUP // N_POOL_GROUPS
POOL_HIST = max(POOL_WINDOWS) - 1
CONF_K = 31
SCONV_K = 3
MLP_CHUNK = 128
MLP_HEADS = 4
MLP_HD = W_GROUP // MLP_HEADS
D_IN = 8 * W_GROUP
D_FF = ((-(-8 * D_MODEL // 3) + 255) // 256) * 256
EPS = 1e-6

kernel_name = "hybrid_streaming_encoder_step"


def rms_norm(x, g):
    xf = x.astype(jnp.float32)
    y = xf * lax.rsqrt(jnp.mean(xf * xf, axis=-1, keepdims=True) + EPS)
    return (y * g.astype(jnp.float32)).astype(x.dtype)


def causal_depthwise(xh, w):
    return lax.conv_general_dilated(
        xh, w[:, None, :].astype(xh.dtype), (1,), 'VALID',
        dimension_numbers=('NWC', 'WIO', 'NWC'), feature_group_count=xh.shape[-1])


def pool_mixer(xh, start_pos, w_pool, scale):
    B, T, C = xh.shape
    L = T - POOL_HIST
    xf = xh.astype(jnp.float32)
    cs = jnp.concatenate([jnp.zeros((B, 1, C), jnp.float32), jnp.cumsum(xf, axis=1)], axis=1)
    pos = start_pos + jnp.arange(L)
    outs = []
    for g, w in enumerate(POOL_WINDOWS):
        sl = slice(g * POOL_GC, (g + 1) * POOL_GC)
        s = cs[:, POOL_HIST + 1:POOL_HIST + 1 + L, sl] - cs[:, POOL_HIST + 1 - w:POOL_HIST + 1 - w + L, sl]
        cnt = jnp.minimum(w, pos + 1).astype(jnp.float32)
        outs.append(s / cnt[None, :, None] - xf[:, POOL_HIST:, sl])
    p = jnp.stack(outs, axis=2)
    y = jnp.einsum('blgc,gcd->blgd', p, w_pool.astype(jnp.float32)).reshape(B, L, C)
    y = y * scale.astype(jnp.float32)
    return y.astype(xh.dtype), xh[:, -POOL_HIST:]


def conformer_conv(a, gate, hist, w_dw, b_dw, ln_g, ln_b):
    z = a * jax.nn.sigmoid(gate)
    zh = jnp.concatenate([hist.astype(z.dtype), z], axis=1)
    c = (causal_depthwise(zh, w_dw) + b_dw).astype(jnp.float32)
    mu = jnp.mean(c, axis=-1, keepdims=True)
    var = jnp.mean(jnp.square(c - mu), axis=-1, keepdims=True)
    n = (c - mu) * lax.rsqrt(var + EPS) * ln_g.astype(jnp.float32) + ln_b.astype(jnp.float32)
    return jax.nn.silu(n).astype(a.dtype), zh[:, -(CONF_K - 1):]


def short_conv(xs, bg, cg, hist, w):
    z = cg * xs
    zh = jnp.concatenate([hist.astype(z.dtype), z], axis=1)
    return bg * causal_depthwise(zh, w), zh[:, -(SCONV_K - 1):]


def chunk_mlp(u, v, w_s, b_s):
    B, L, C = v.shape
    Lc = min(L, MLP_CHUNK)
    n = L // Lc
    ws = w_s[:, :Lc, :Lc] * jnp.tril(jnp.ones((Lc, Lc), w_s.dtype))
    vr = v.reshape(B, n, Lc, MLP_HEADS, MLP_HD)
    mixed = jnp.einsum('hij,bnjhd->bnihd', ws, vr) + b_s[:, :Lc].T[None, None, :, :, None]
    return u * mixed.reshape(B, L, C).astype(u.dtype)


def run_trunk(x, start_pos, pool_h, conv_h, sc_h, g_mix, w_in, w_pool, pool_scale,
              w_conf_dw, b_conf_dw, conf_ln_g, conf_ln_b, w_sconv, w_s, b_s, w_out,
              g_ffn, w_gate, w_up, w_down, g_final):
    B = x.shape[0]
    new_pool, new_conv, new_sc, new_v = [], [], [], []
    for l in range(DEPTH):
        if pool_h is None:
            ph = jnp.zeros((B, POOL_HIST, W_GROUP), x.dtype)
            ch = jnp.zeros((B, CONF_K - 1, W_GROUP), x.dtype)
            sh = jnp.zeros((B, SCONV_K - 1, W_GROUP), x.dtype)
        else:
            ph, ch, sh = pool_h[l].astype(x.dtype), conv_h[l], sc_h[l]
        h = rms_norm(x, g_mix[l])
        p = jnp.einsum('bld,de->ble', h, w_in[l])
        seg = [p[..., i * W_GROUP:(i + 1) * W_GROUP] for i in range(8)]
        ya, ph_new = pool_mixer(jnp.concatenate([ph, seg[0]], axis=1), start_pos, w_pool[l], pool_scale[l])
        yb, ch_new = conformer_conv(seg[1], seg[2], ch, w_conf_dw[l], b_conf_dw[l], conf_ln_g[l], conf_ln_b[l])
        yc, sh_new = short_conv(seg[3], seg[4], seg[5], sh, w_sconv[l])
        yd = chunk_mlp(seg[6], seg[7], w_s[l], b_s[l])
        mix = jnp.concatenate([ya, yb, yc, yd], axis=-1)
        x = x + jnp.einsum('ble,ed->bld', mix, w_out[l])
        f = rms_norm(x, g_ffn[l])
        hid = jax.nn.silu(jnp.einsum('bld,df->blf', f, w_gate[l])) * jnp.einsum('bld,df->blf', f, w_up[l])
        x = x + jnp.einsum('blf,fd->bld', hid, w_down[l])
        new_pool.append(ph_new)
        new_conv.append(ch_new)
        new_sc.append(sh_new)
        new_v.append(seg[7])
    y = rms_norm(x, g_final)
    return y, jnp.stack(new_pool), jnp.stack(new_conv), jnp.stack(new_sc), jnp.stack(new_v)


def setup_inputs(seed: int = 0) -> dict:
    key = jax.random.key(seed)
    ks = jax.random.split(key, 24)
    nrm = lambda k, s, sc: jax.random.normal(k, s, jnp.float32) * sc
    return {
        "x_prompt": nrm(ks[0], (BATCH, SEQ, D_MODEL), 1.0),
        "x_sample": nrm(ks[1], (DEC_BATCH, DEC_SEQ, D_MODEL), 1.0),
        "state_pool": nrm(ks[2], (DEPTH, DEC_BATCH, POOL_HIST, W_GROUP), 1.0),
        "state_conv": nrm(ks[3], (DEPTH, DEC_BATCH, CONF_K - 1, W_GROUP), 0.5),
        "state_short_conv": nrm(ks[4], (DEPTH, DEC_BATCH, SCONV_K - 1, W_GROUP), 0.5),
        "g_mix": 1.0 + nrm(ks[5], (DEPTH, D_MODEL), 0.1),
        "w_in": nrm(ks[6], (DEPTH, D_MODEL, D_IN), D_MODEL ** -0.5),
        "w_pool": nrm(ks[7], (DEPTH, N_POOL_GROUPS, POOL_GC, POOL_GC), POOL_GC ** -0.5),
        "pool_scale": 1.0 + nrm(ks[8], (DEPTH, W_GROUP), 0.1),
        "w_conf_dw": nrm(ks[9], (DEPTH, CONF_K, W_GROUP), CONF_K ** -0.5),
        "b_conf_dw": nrm(ks[10], (DEPTH, W_GROUP), 0.02),
        "conf_ln_g": 1.0 + nrm(ks[11], (DEPTH, W_GROUP), 0.1),
        "conf_ln_b": nrm(ks[12], (DEPTH, W_GROUP), 0.02),
        "w_sconv": nrm(ks[13], (DEPTH, SCONV_K, W_GROUP), SCONV_K ** -0.5),
        "w_s": nrm(ks[14], (DEPTH, MLP_HEADS, MLP_CHUNK, MLP_CHUNK), MLP_CHUNK ** -0.5),
        "b_s": 1.0 + nrm(ks[15], (DEPTH, MLP_HEADS, MLP_CHUNK), 0.1),
        "w_out": nrm(ks[16], (DEPTH, D_MIX, D_MODEL), D_MIX ** -0.5),
        "g_ffn": 1.0 + nrm(ks[17], (DEPTH, D_MODEL), 0.1),
        "w_gate": nrm(ks[18], (DEPTH, D_MODEL, D_FF), D_MODEL ** -0.5),
        "w_up": nrm(ks[19], (DEPTH, D_MODEL, D_FF), D_MODEL ** -0.5),
        "w_down": nrm(ks[20], (DEPTH, D_FF, D_MODEL), D_FF ** -0.5),
        "g_final": 1.0 + nrm(ks[21], (D_MODEL,), 0.1),
    }


def reference(x_prompt, x_sample, state_pool, state_conv, state_short_conv, g_mix, w_in,
              w_pool, pool_scale, w_conf_dw, b_conf_dw, conf_ln_g, conf_ln_b, w_sconv,
              w_s, b_s, w_out, g_ffn, w_gate, w_up, w_down, g_final):
    assert x_sample.shape[1] <= CHUNK
    weights = (g_mix, w_in, w_pool, pool_scale, w_conf_dw, b_conf_dw, conf_ln_g, conf_ln_b,
               w_sconv, w_s, b_s, w_out, g_ffn, w_gate, w_up, w_down, g_final)
    y_prompt, pool_p, conv_p, sc_p, _ = run_trunk(x_prompt, 0, None, None, None, *weights)
    y_sample, pool_s, conv_s, sc_s, v_s = run_trunk(
        x_sample, PAST_LEN, state_pool, state_conv, state_short_conv, *weights)
    return (y_prompt, y_sample, pool_p, pool_s, conv_p, conv_s, sc_p, sc_s, v_s)
```

```cpp
#include <hip/hip_runtime.h>
#include <hip/hip_cooperative_groups.h>
#include <cstdio>
#include <cstdint>
namespace cg = cooperative_groups;
namespace pg8 {
#define PG8_LAS __attribute__((address_space(3)))
typedef unsigned short bf16_t;
typedef short bf16x8 __attribute__((ext_vector_type(8)));
typedef float f32x4 __attribute__((ext_vector_type(4)));
typedef unsigned u32x4 __attribute__((ext_vector_type(4)));
constexpr int BM = 256, BK = 64, HALF = 128, HTB = HALF * BK * 2  , STAGE_BYTES = 8 * HTB, NXCD = 8, WGM = 8;

__host__ __device__ __forceinline__ int lds_byte(int r, int c) { const int st = (r >> 4) * 2 + (c >> 5), rr = r & 15, cc = c & 31, ob = rr * 64 + cc * 2; return st * 1024 + (ob ^ (((ob >> 9) & 1) << 5)); }
__host__ __device__ __forceinline__ void stage_rc(int b, int& R, int& C) { const int st = b / 1024, sb = b % 1024, swz = sb ^ (((sb >> 9) & 1) << 5); R = (st >> 1) * 16 + swz / 64; C = (st & 1) * 32 + (swz % 64) / 2; }
__host__ __device__ __forceinline__ int perm32(int rho) { const int n = rho >> 4, i = rho & 15; return 8 * (i >> 2) + 4 * n + (i & 3); }

struct Unit { int pm, pn; };
struct Gemm { const bf16_t* A; const bf16_t* Bt; int M, N, K; };

struct StaticOrder {
    int nM, nN, nwg, G, c;
    __host__ __device__ void init(int M, int N, int G_, int c_) { nM = M / BM; nN = N / BM; nwg = nM * nN; G = G_; c = c_; }
    __host__ __device__ bool next(int i, Unit& u) const {
        const long L = (long)i * G + c; if (L >= nwg) return false;
        int wgid = (int)L; { const int q = nwg / NXCD, r = nwg % NXCD, xcd = wgid % NXCD, off = wgid / NXCD; wgid = (xcd < r ? xcd * (q + 1) : r * (q + 1) + (xcd - r) * q) + off; }
        const int nig = WGM * nN, gid = wgid / nig, fm = gid * WGM, gsz = (nM - fm) < WGM ? (nM - fm) : WGM;
        u.pm = fm + ((wgid % nig) % gsz); u.pn = (wgid % nig) / gsz; return true;
    }
    __device__ __forceinline__ void a_ready(const Unit&) const {}
    __device__ __forceinline__ void done(const Unit&) const {}
};
__device__ __forceinline__ unsigned cvt_pk_bf16(float lo, float hi) { unsigned r; asm volatile("v_cvt_pk_bf16_f32 %0, %1, %2" : "=v"(r) : "v"(lo), "v"(hi)); return r; }
typedef float f32x2 __attribute__((ext_vector_type(2)));
__device__ __forceinline__ int pg8_tid(PG8_LAS unsigned char* lds) {
    const int slot = (int)__builtin_amdgcn_s_getreg((5 << 11) | 4) & 63;
    const int w = ((volatile PG8_LAS int*)(lds + 131072 + 256))[slot];
    return __builtin_amdgcn_readfirstlane(w) * 64 + (int)__builtin_amdgcn_mbcnt_hi(~0u, __builtin_amdgcn_mbcnt_lo(~0u, 0u));
}
template <class Epi, class Sched, bool ALIGN_EPI = false, bool SP2 = false>
__device__ __forceinline__ void gemm_phase(PG8_LAS unsigned char* lds, const Gemm g, const Sched& S, const Epi& E) {
    int tid_l = pg8_tid(lds); asm volatile("" : "+v"(tid_l));
    const int tid = tid_l, wid = __builtin_amdgcn_readfirstlane(tid >> 6), lane = tid & 63, wr = wid >> 2, wc = wid & 3, fr = lane & 15, fq = lane >> 4;
    const int K = g.K, nt = K / BK;
    unsigned voffA[2], voffB[2];
#pragma unroll
    for (int i = 0; i < 2; ++i) { int R, C; stage_rc(tid * 16 + i * 8192, R, C); const int Rb = Epi::PERM ? ((R & ~31) + perm32(R & 31)) : R;
        voffA[i] = (unsigned)(R * K + C) * 2u; voffB[i] = (unsigned)(Rb * K + C) * 2u; }
    const size_t kstep = (size_t)(BK * 2);
    const size_t hstep = (size_t)HALF * K * 2;
    const size_t tstep = 2 * hstep;
    const unsigned ldsw = (unsigned)wid * 1024u;
    const int aoff = lds_byte(wr * 64 + fr, fq * 8), boff = lds_byte(wc * 32 + fr, fq * 8);
#define PG8_SA(b, h) (((b) * 2 + (h)) * HTB)
#define PG8_SB(b, h) ((4 + (b) * 2 + (h)) * HTB)
#define PG8_STAGE(bufoff, gbase, voff) do { _Pragma("unroll") for (int _i = 0; _i < 2; ++_i) \
        __builtin_amdgcn_global_load_lds((const unsigned*)((const char*)(gbase) + (voff)[_i]), (PG8_LAS unsigned*)(lds + (bufoff) + ldsw + _i * 8192), 16, 0, 0); } while (0)
#define PG8_LDA(dst, b, h) do { _Pragma("unroll") for (int m = 0; m < 4; ++m) _Pragma("unroll") for (int k = 0; k < 2; ++k) dst[m][k] = *(const PG8_LAS bf16x8*)(lds + PG8_SA(b, h) + aoff + m * 2048 + k * 1024); } while (0)
#define PG8_LDB(dst, b, h) do { _Pragma("unroll") for (int n = 0; n < 2; ++n) _Pragma("unroll") for (int k = 0; k < 2; ++k) dst[n][k] = *(const PG8_LAS bf16x8*)(lds + PG8_SB(b, h) + boff + n * 2048 + k * 1024); } while (0)
#define PG8_MMA(ai, bj, At, Bt) do { __builtin_amdgcn_s_setprio(1); _Pragma("unroll") for (int m = 0; m < 4; ++m) _Pragma("unroll") for (int n = 0; n < 2; ++n) _Pragma("unroll") for (int k = 0; k < 2; ++k) \
        acc[ai][bj][m][n] = __builtin_amdgcn_mfma_f32_16x16x32_bf16(Bt[n][k], At[m][k], acc[ai][bj][m][n], 0, 0, 0); __builtin_amdgcn_s_setprio(0); } while (0)
#define PG8_WAIT_V(n) asm volatile("s_waitcnt vmcnt(" #n ")" ::: "memory")
#define PG8_WAIT_L(n) asm volatile("s_waitcnt lgkmcnt(" #n ")" ::: "memory")
#define PG8_BAR __builtin_amdgcn_s_barrier()
#define PG8_SCHED __builtin_amdgcn_sched_barrier(0)
    Unit cur, nxt; int ui = 0;
    if (!S.next(0, cur)) return;
    f32x4 acc[2][2][4][2];
#pragma unroll
    for (int a = 0; a < 2; ++a)
#pragma unroll
        for (int b = 0; b < 2; ++b)
#pragma unroll
            for (int m = 0; m < 4; ++m)
#pragma unroll
                for (int n = 0; n < 2; ++n) acc[a][b][m][n] = (f32x4){0.f, 0.f, 0.f, 0.f};
    bf16x8 At[4][2], B0[2][2], B1[2][2];
    const char* cA = (const char*)g.A + (size_t)cur.pm * tstep; const char* cB = (const char*)g.Bt + (size_t)cur.pn * tstep;
    S.a_ready(cur);
    if constexpr (SP2) {
        PG8_STAGE(PG8_SB(0, 0), cB, voffB); PG8_STAGE(PG8_SB(0, 1), cB + hstep, voffB); PG8_STAGE(PG8_SA(0, 0), cA, voffA); PG8_STAGE(PG8_SA(0, 1), cA + hstep, voffA);
        if (wr == 1) PG8_BAR;
        PG8_WAIT_V(2); PG8_BAR;
        PG8_STAGE(PG8_SB(1, 0), cB + kstep, voffB); PG8_STAGE(PG8_SA(1, 0), cA + kstep, voffA); PG8_STAGE(PG8_SB(1, 1), cB + hstep + kstep, voffB);
        PG8_WAIT_V(6); PG8_BAR;
    } else {
        PG8_STAGE(PG8_SB(0, 0), cB, voffB); PG8_STAGE(PG8_SA(0, 0), cA, voffA); PG8_STAGE(PG8_SB(0, 1), cB + hstep, voffB); PG8_STAGE(PG8_SA(0, 1), cA + hstep, voffA);
        if (wr == 1) PG8_BAR;
        PG8_WAIT_V(4); PG8_BAR;
        PG8_STAGE(PG8_SB(1, 0), cB + kstep, voffB); PG8_STAGE(PG8_SA(1, 0), cA + kstep, voffA); PG8_STAGE(PG8_SB(1, 1), cB + hstep + kstep, voffB);
        PG8_WAIT_V(6); PG8_BAR;
    }
    for (;;) {
        const bool has_next = S.next(ui + 1, nxt);
        const char* nA = has_next ? (const char*)g.A + (size_t)nxt.pm * tstep : cA; const char* nB = has_next ? (const char*)g.Bt + (size_t)nxt.pn * tstep : cB;
        for (int t = 0; t < nt; t += 2) {
            const bool last = (t == nt - 2);
            const char* a1 = cA + (size_t)(t + 1) * kstep;
            const char* a2 = last ? nA : cA + (size_t)(t + 2) * kstep; const char* b2 = last ? nB : cB + (size_t)(t + 2) * kstep;
            const char* a3 = a2 + kstep; const char* b3 = b2 + kstep;
            if (last && has_next) S.a_ready(nxt);
            if constexpr (SP2) {
            PG8_LDB(B0, 0, 0); PG8_LDB(B1, 0, 1); PG8_SCHED; PG8_LDA(At, 0, 0); PG8_STAGE(PG8_SA(1, 1), a1 + hstep, voffA);
            PG8_WAIT_V(8); PG8_WAIT_L(0); PG8_BAR; PG8_MMA(0, 0, At, B0); PG8_MMA(0, 1, At, B1); PG8_BAR; PG8_SCHED;
            PG8_LDA(At, 0, 1); PG8_STAGE(PG8_SB(0, 0), b2, voffB); PG8_STAGE(PG8_SB(0, 1), b2 + hstep, voffB); PG8_STAGE(PG8_SA(0, 0), a2, voffA);
            PG8_WAIT_V(8); PG8_WAIT_L(0); PG8_BAR; PG8_MMA(1, 0, At, B0); PG8_MMA(1, 1, At, B1); PG8_BAR; PG8_SCHED;
            PG8_LDB(B0, 1, 0); PG8_LDB(B1, 1, 1); PG8_SCHED; PG8_LDA(At, 1, 0); PG8_STAGE(PG8_SA(0, 1), a2 + hstep, voffA);
            PG8_WAIT_V(8); PG8_WAIT_L(0); PG8_BAR; PG8_MMA(0, 0, At, B0); PG8_MMA(0, 1, At, B1); PG8_BAR; PG8_SCHED;
            PG8_LDA(At, 1, 1); PG8_STAGE(PG8_SB(1, 0), b3, voffB); PG8_STAGE(PG8_SB(1, 1), b3 + hstep, voffB); PG8_STAGE(PG8_SA(1, 0), a3, voffA);
            PG8_WAIT_V(8); PG8_WAIT_L(0); PG8_BAR; PG8_MMA(1, 0, At, B0); PG8_MMA(1, 1, At, B1); PG8_BAR; PG8_SCHED;
            } else {
            PG8_LDB(B0, 0, 0); PG8_SCHED; PG8_LDA(At, 0, 0); PG8_STAGE(PG8_SA(1, 1), a1 + hstep, voffA);
            PG8_WAIT_L(8); PG8_BAR; PG8_WAIT_L(0); PG8_MMA(0, 0, At, B0); PG8_BAR; PG8_SCHED;
            PG8_LDB(B1, 0, 1); PG8_STAGE(PG8_SB(0, 0), b2, voffB);
            PG8_BAR; PG8_WAIT_L(0); PG8_MMA(0, 1, At, B1); PG8_BAR;
            PG8_LDA(At, 0, 1); PG8_STAGE(PG8_SA(0, 0), a2, voffA);
            PG8_BAR; PG8_WAIT_L(0); PG8_MMA(1, 0, At, B0); PG8_BAR; PG8_SCHED;
            PG8_STAGE(PG8_SB(0, 1), b2 + hstep, voffB);
            PG8_WAIT_V(6); PG8_BAR; PG8_MMA(1, 1, At, B1); PG8_BAR;
            PG8_LDB(B0, 1, 0); PG8_SCHED; PG8_LDA(At, 1, 0); PG8_STAGE(PG8_SA(0, 1), a2 + hstep, voffA);
            PG8_WAIT_L(8); PG8_BAR; PG8_WAIT_L(0); PG8_MMA(0, 0, At, B0); PG8_BAR; PG8_SCHED;
            PG8_LDB(B1, 1, 1); PG8_STAGE(PG8_SB(1, 0), b3, voffB);
            PG8_BAR; PG8_WAIT_L(0); PG8_MMA(0, 1, At, B1); PG8_BAR;
            PG8_LDA(At, 1, 1); PG8_STAGE(PG8_SA(1, 0), a3, voffA);
            PG8_BAR; PG8_WAIT_L(0); PG8_MMA(1, 0, At, B0); PG8_BAR; PG8_SCHED;
            PG8_STAGE(PG8_SB(1, 1), b3 + hstep, voffB);
            PG8_WAIT_V(6); PG8_BAR; PG8_MMA(1, 1, At, B1); PG8_BAR;
            }
        }
        if constexpr (ALIGN_EPI) { if (wr == 0) PG8_BAR; }
        if constexpr (!Epi::AFTER_DRAIN) { E(acc, cur, wr, wc, fr, fq); S.done(cur); }
        if (!has_next) break;
#pragma unroll
        for (int a = 0; a < 2; ++a)
#pragma unroll
            for (int b = 0; b < 2; ++b)
#pragma unroll
                for (int m = 0; m < 4; ++m)
#pragma unroll
                    for (int n = 0; n < 2; ++n) acc[a][b][m][n] = (f32x4){0.f, 0.f, 0.f, 0.f};
        cur = nxt; cA = nA; cB = nB; ++ui;
        if constexpr (ALIGN_EPI) { if (wr == 1) PG8_BAR; }
    }
    PG8_WAIT_V(0);
    if constexpr (!ALIGN_EPI) { if (wr == 0) PG8_BAR; }
    PG8_BAR;
    if constexpr (Epi::AFTER_DRAIN) { E.fused(acc, cur, wr, wc, fr, fq, lds, wid, lane); S.done(cur); }
#undef PG8_SA
#undef PG8_SB
#undef PG8_STAGE
#undef PG8_LDA
#undef PG8_LDB
#undef PG8_MMA
#undef PG8_WAIT_V
#undef PG8_WAIT_L
#undef PG8_BAR
#undef PG8_SCHED
}
}

#ifndef EXP_MIXMASK
#define EXP_MIXMASK 15
#endif
#ifndef EXP_DUPMASK
#define EXP_DUPMASK 15
#endif
#ifndef EXP_DUP
#define EXP_DUP 0
#endif
#ifndef EXP_STOP
#define EXP_STOP 10
#endif
#define LAS __attribute__((address_space(3)))
typedef unsigned short bf16_t;
typedef float f32x4 __attribute__((ext_vector_type(4)));
typedef float f32x2 __attribute__((ext_vector_type(2)));
typedef unsigned u32x4 __attribute__((ext_vector_type(4)));
typedef unsigned u32x2 __attribute__((ext_vector_type(2)));
typedef short bf16x8 __attribute__((ext_vector_type(8)));

constexpr int DM = 1024, NBP = 16, SEQ = 4096, MP = NBP * SEQ, NBS = 8, DSQ = 32, MS = NBS * DSQ, MT = MP + MS;
constexpr int DIN = 2048, DP = 1536, PC_Z = 256, PC_ZS = 512, PC_B = 768, PC_U = 1024, PC_V = 1280, DFF = 2816, NGU = 2 * DFF, WG = 256, PAST = 1024;
constexpr float EPS = 1e-6f;
constexpr size_t MiB = 1u << 20;
constexpr size_t WS_WIN = 0, WS_WOUT = 8 * MiB, WS_WGU = 12 * MiB, WS_WDN = 34 * MiB, WS_WPT = 45 * MiB, WS_WST = 45 * MiB + 65536;
constexpr size_t WS_SSQA = 46 * MiB, WS_SSQB = 51 * MiB, WS_SMALL = 56 * MiB, WS_CTL = 60 * MiB, CTL_BYTES = 16384, WS_HIDS = 61 * MiB;
constexpr int SP_WDW = 0, SP_BDW = SP_WDW + 2 * 31 * 256, SP_LNG = SP_BDW + 512, SP_LNB = SP_LNG + 512, SP_WSC = SP_LNB + 512, SP_BS = SP_WSC + 2 * 3 * 256, SP_GF = SP_BS + 2 * 4 * 128,
              SP_STP = SP_GF + 1024, SP_STC = SP_STP + 2 * 8 * 15 * 256, SP_STS = SP_STC + 2 * 8 * 30 * 256, SP_END = SP_STS + 2 * 8 * 2 * 256;
static_assert(WS_SMALL + (size_t)SP_END * 4 <= WS_CTL && WS_HIDS + (size_t)MS * DFF * 2 <= 64 * MiB, "ws map small");
constexpr size_t WS_XB = 64 * MiB, WS_X = 193 * MiB, WS_P = 450 * MiB, WS_MIX = 707 * MiB, WS_HID = 450 * MiB, WS_PART = 836 * MiB, WS_WDNS = 840 * MiB, WS_END = 852 * MiB;
constexpr int KH = DFF / 2;
static_assert(WS_PART + 2ull * MS * DM * 4 <= WS_WDNS && WS_WDNS + 2ull * 2 * DM * KH * 2 <= WS_END && KH % 128 == 0 && KH % 64 == 0, "split-K buffers");
static_assert(WS_XB + (size_t)MT * DM * 2 <= WS_X && WS_X + (size_t)MT * DM * 4 <= WS_P && WS_P + (size_t)MT * DIN * 2 <= WS_MIX && WS_MIX + (size_t)MT * DM * 2 <= WS_PART && WS_HID + (size_t)MT * DFF * 2 <= WS_PART, "ws map");
static_assert(WS_SSQA + (size_t)MT * 64 <= WS_SSQB && WS_SSQB + (size_t)MT * 64 <= WS_XB, "ws map ssq");
constexpr size_t O_Y = 0, O_POOLP = (size_t)MT * DM, O_POOLS = O_POOLP + 2 * 16 * 15 * 256, O_CONVP = O_POOLS + 2 * 8 * 15 * 256, O_CONVS = O_CONVP + 2 * 16 * 30 * 256,
                 O_SCP = O_CONVS + 2 * 8 * 30 * 256, O_SCS = O_SCP + 2 * 16 * 2 * 256, O_VS = O_SCS + 2 * 8 * 2 * 256, O_END = O_VS + 2 * 8 * 32 * 256;
constexpr int LDS_BYTES = 135168;

__device__ __forceinline__ float bf_lo(unsigned u) { return __uint_as_float(u << 16); }
__device__ __forceinline__ float bf_hi(unsigned u) { return __uint_as_float(u & 0xffff0000u); }
typedef __bf16 bf16x2_t __attribute__((ext_vector_type(2)));
__device__ __forceinline__ unsigned pk_bf16(float lo, float hi) { const f32x2 v = {lo, hi}; const bf16x2_t b = __builtin_convertvector(v, bf16x2_t); return __builtin_bit_cast(unsigned, b); }
__device__ __forceinline__ float wave_sum(float v) {
#pragma unroll
    for (int o = 1; o < 64; o <<= 1) v += __shfl_xor(v, o);
    return v;
}
__device__ __forceinline__ float sigmoidf_(float x) { return 1.0f / (1.0f + __expf(-x)); }

__device__ __forceinline__ float row_rstd(const float* ssq, int row, int fq) {
    const f32x4 s = *(const f32x4*)(ssq + (size_t)row * 16 + 4 * fq);
    float t = (s[0] + s[1]) + (s[2] + s[3]);
    t += __shfl_xor(t, 16); t += __shfl_xor(t, 32);
    return rsqrtf(t * (1.0f / DM) + EPS);
}
struct EpiInProj {
    static constexpr bool PERM = true, AFTER_DRAIN = false;
    bf16_t* P; const float* ssq;
    __device__ __forceinline__ void operator()(const f32x4 (&acc)[2][2][4][2], const pg8::Unit& u, int wr, int wc, int fr, int fq) const {
        asm volatile("" : "+v"(fr));
        const int row0 = u.pm * 256 + wr * 64 + fr, pn = u.pn;
        const int mode = (pn == 1 || pn == 2) ? 1 : ((pn == 3 || pn == 4) ? 2 : 0);
        const int dcol = (pn == 0) ? 0 : (mode == 1 ? PC_Z + 128 * (pn - 1) : (mode == 2 ? PC_ZS + 128 * (pn - 3) : PC_B + 256 * (pn - 5)));
        const int col0 = dcol + wc * 32 + 8 * fq;
#pragma unroll
        for (int ai = 0; ai < 2; ++ai)
#pragma unroll
            for (int m = 0; m < 4; ++m) {
                const int row = row0 + ai * 128 + m * 16; const float rs = row_rstd(ssq, row, fq);
                bf16_t* rowp = P + (size_t)row * DP + col0;
                if (mode == 0) {
#pragma unroll
                    for (int bj = 0; bj < 2; ++bj) { const f32x4 v0 = acc[ai][bj][m][0] * rs, v1 = acc[ai][bj][m][1] * rs;
                        u32x4 w; w.x = pk_bf16(v0[0], v0[1]); w.y = pk_bf16(v0[2], v0[3]); w.z = pk_bf16(v1[0], v1[1]); w.w = pk_bf16(v1[2], v1[3]);
                        __builtin_nontemporal_store(w, (u32x4*)(rowp + bj * 128)); }
                } else {
                    float h[8];
                    const float c1 = rs * -1.4426950408889634f, rs2 = rs * rs;
#pragma unroll
                    for (int n = 0; n < 2; ++n)
#pragma unroll
                        for (int j = 0; j < 4; j += 2) { const f32x2 a = {acc[ai][0][m][n][j], acc[ai][0][m][n][j + 1]}, b = {acc[ai][1][m][n][j], acc[ai][1][m][n][j + 1]};
                            f32x2 hh;
                            if (mode == 1) { const f32x2 t = b * c1; f32x2 e; e.x = __builtin_amdgcn_exp2f(t.x); e.y = __builtin_amdgcn_exp2f(t.y);
                                const f32x2 d = e + 1.0f; f32x2 r; r.x = __builtin_amdgcn_rcpf(d.x); r.y = __builtin_amdgcn_rcpf(d.y); hh = (a * rs) * r; }
                            else hh = (a * b) * rs2;
                            h[n * 4 + j] = hh.x; h[n * 4 + j + 1] = hh.y; }
                    u32x4 w; w.x = pk_bf16(h[0], h[1]); w.y = pk_bf16(h[2], h[3]); w.z = pk_bf16(h[4], h[5]); w.w = pk_bf16(h[6], h[7]);
                    __builtin_nontemporal_store(w, (u32x4*)rowp);
                }
            }
    }
};
struct EpiSwiGLU {
    static constexpr bool PERM = true, AFTER_DRAIN = false;
    bf16_t* H; const float* ssq;
    __device__ __forceinline__ void operator()(const f32x4 (&acc)[2][2][4][2], const pg8::Unit& u, int wr, int wc, int fr, int fq) const {
        asm volatile("" : "+v"(fr));
        const int row0 = u.pm * 256 + wr * 64 + fr, col0 = u.pn * 128 + wc * 32 + 8 * fq;
#pragma unroll
        for (int ai = 0; ai < 2; ++ai)
#pragma unroll
            for (int m = 0; m < 4; ++m) {
                const int row = row0 + ai * 128 + m * 16; const float rs = row_rstd(ssq, row, fq);
                float h[8];
                const float c1 = rs * -1.4426950408889634f, rs2 = rs * rs;
#pragma unroll
                for (int n = 0; n < 2; ++n)
#pragma unroll
                    for (int j = 0; j < 4; j += 2) { const f32x2 ag = {acc[ai][0][m][n][j], acc[ai][0][m][n][j + 1]}, au = {acc[ai][1][m][n][j], acc[ai][1][m][n][j + 1]};
                        const f32x2 t = ag * c1; f32x2 e; e.x = __builtin_amdgcn_exp2f(t.x); e.y = __builtin_amdgcn_exp2f(t.y);
                        const f32x2 d = e + 1.0f; f32x2 r; r.x = __builtin_amdgcn_rcpf(d.x); r.y = __builtin_amdgcn_rcpf(d.y);
                        const f32x2 hh = (ag * au) * (r * rs2); h[n * 4 + j] = hh.x; h[n * 4 + j + 1] = hh.y; }
                u32x4 w; w.x = pk_bf16(h[0], h[1]); w.y = pk_bf16(h[2], h[3]); w.z = pk_bf16(h[4], h[5]); w.w = pk_bf16(h[6], h[7]);
                __builtin_nontemporal_store(w, (u32x4*)(H + (size_t)row * DFF + col0));
            }
    }
};
struct EpiResid {
    static constexpr bool PERM = false, AFTER_DRAIN = false;
    const float* rp; bf16_t* XB; float* ssq;
    __device__ __forceinline__ void operator()(const f32x4 (&acc)[2][2][4][2], const pg8::Unit& u, int wr, int wc, int fr, int fq) const {
        asm volatile("" : "+v"(fr));
        const int row0 = u.pm * 256 + wr * 64 + fr, col0 = u.pn * 256 + wc * 32 + 4 * fq;
        const bool rf32 = (rp != nullptr) && (u.pm < MP / 256);
#pragma unroll
        for (int ai = 0; ai < 2; ++ai)
#pragma unroll
            for (int m = 0; m < 4; ++m) {
                const int row = row0 + ai * 128 + m * 16; const size_t off = (size_t)row * DM + col0; float q = 0.f;
                f32x4 r4[2][2];
                if (rf32) {
#pragma unroll
                    for (int bj = 0; bj < 2; ++bj)
#pragma unroll
                        for (int n = 0; n < 2; ++n) r4[bj][n] = *(const f32x4*)(rp + off + bj * 128 + n * 16);
                } else {
#pragma unroll
                    for (int bj = 0; bj < 2; ++bj)
#pragma unroll
                        for (int n = 0; n < 2; ++n) { const u32x2 w = *(const u32x2*)(XB + off + bj * 128 + n * 16); r4[bj][n] = (f32x4){bf_lo(w.x), bf_hi(w.x), bf_lo(w.y), bf_hi(w.y)}; }
                }
#pragma unroll
                for (int bj = 0; bj < 2; ++bj)
#pragma unroll
                    for (int n = 0; n < 2; ++n) { const f32x4 x4 = r4[bj][n] + acc[ai][bj][m][n];
                        q += (x4[0] * x4[0] + x4[1] * x4[1]) + (x4[2] * x4[2] + x4[3] * x4[3]);
                        u32x2 w; w.x = pk_bf16(x4[0], x4[1]); w.y = pk_bf16(x4[2], x4[3]); *(u32x2*)(XB + off + bj * 128 + n * 16) = w; }
                q += __shfl_xor(q, 16); q += __shfl_xor(q, 32);
                if (fq == 0) ssq[(size_t)row * 16 + u.pn * 4 + wc] = q;
                if (m & 1) asm volatile("" ::: "memory");
            }
    }
};

struct Params {
    const float* x_prompt; const float* x_sample; const float* st_pool; const float* st_conv; const float* st_sc; const float* g_mix; const float* w_in; const float* w_pool;
    const float* pool_scale; const float* w_dw; const float* b_dw; const float* ln_g; const float* ln_b; const float* w_sconv; const float* w_s; const float* b_s; const float* w_out;
    const float* g_ffn; const float* w_gate; const float* w_up; const float* w_down; const float* g_final;
    float* out; unsigned char* ws;
};

__device__ __forceinline__ void transpose_item(const float* W, const float* gk, int K, int N, bf16_t* WT, int dst_row0, LAS float* scr, int k0, int n0, int lane, bf16_t* WT2 = nullptr, int K2 = 0, int k02 = 0) {
    float tv[32];
#pragma unroll
    for (int i = 0; i < 32; ++i) { const int kk = 2 * i + (lane >> 5); tv[i] = W[(size_t)(k0 + kk) * N + n0 + (lane & 31)]; }
#pragma unroll
    for (int i = 0; i < 32; ++i) { const int kk = 2 * i + (lane >> 5); float v = tv[i]; if (gk) v *= gk[k0 + kk]; scr[kk * 33 + (lane & 31)] = v; }
    asm volatile("s_waitcnt lgkmcnt(0)" ::: "memory");
    const int c = lane & 7;
#pragma unroll
    for (int j = 0; j < 4; ++j) { const int n = (lane >> 3) + 8 * j; const LAS float* s = scr + (8 * c) * 33 + n;
        u32x4 o; o.x = pk_bf16(s[0 * 33], s[1 * 33]); o.y = pk_bf16(s[2 * 33], s[3 * 33]); o.z = pk_bf16(s[4 * 33], s[5 * 33]); o.w = pk_bf16(s[6 * 33], s[7 * 33]);
        *(u32x4*)(WT + (size_t)(dst_row0 + n) * K + k0 + 8 * c) = o;
        if (WT2) *(u32x4*)(WT2 + (size_t)(dst_row0 + n) * K2 + k02 + 8 * c) = o; }
    asm volatile("s_waitcnt lgkmcnt(0)" ::: "memory");
}
__device__ __forceinline__ void prologue(const Params& p, LAS unsigned char* lds, int tid, int lane, int wave) {
    LAS float* scr = (LAS float*)(lds + wave * 16384);
    const int gw = blockIdx.x * 8 + wave, NGW = gridDim.x * 8;
    constexpr int I_IN = (DM / 64) * (DIN / 32), I_OUT = (DM / 64) * (DM / 32), I_G = (DM / 64) * (DFF / 32), I_DN = (DFF / 64) * (DM / 32);
    constexpr int I_LAYER = I_IN + I_OUT + 2 * I_G + I_DN;
    bf16_t* WIN = (bf16_t*)(p.ws + WS_WIN); bf16_t* WOUT = (bf16_t*)(p.ws + WS_WOUT); bf16_t* WGU = (bf16_t*)(p.ws + WS_WGU); bf16_t* WDN = (bf16_t*)(p.ws + WS_WDN);
    for (int it = gw; it < 2 * I_LAYER; it += NGW) {
        const int l = it / I_LAYER; int r = it % I_LAYER;
        if (r < I_IN) { const int nb = DIN / 32, k0 = 64 * (r / nb), n0 = 32 * (r % nb); const int seg = n0 >> 8, off = n0 & 255, hi = off >> 7, lo = off & 127;
            const int drow = (seg == 0) ? off : (seg == 1) ? 256 * (1 + hi) + lo : (seg == 2) ? 256 * (1 + hi) + 128 + lo : (seg == 3) ? 256 * (3 + hi) + lo : (seg == 5) ? 256 * (3 + hi) + 128 + lo : (seg == 4) ? 256 * 5 + off : 256 * seg + off;
            transpose_item(p.w_in + (size_t)l * DM * DIN, p.g_mix + l * DM, DM, DIN, WIN + (size_t)l * DIN * DM, drow, scr, k0, n0, lane); continue; } r -= I_IN;
        if (r < I_OUT) { const int nb = DM / 32, k0 = 64 * (r / nb), n0 = 32 * (r % nb); transpose_item(p.w_out + (size_t)l * DM * DM, nullptr, DM, DM, WOUT + (size_t)l * DM * DM, n0, scr, k0, n0, lane); continue; } r -= I_OUT;
        if (r < I_G) { const int nb = DFF / 32, k0 = 64 * (r / nb), n0 = 32 * (r % nb); transpose_item(p.w_gate + (size_t)l * DM * DFF, p.g_ffn + l * DM, DM, DFF, WGU + (size_t)l * NGU * DM, (n0 >> 7) * 256 + (n0 & 127), scr, k0, n0, lane); continue; } r -= I_G;
        if (r < I_G) { const int nb = DFF / 32, k0 = 64 * (r / nb), n0 = 32 * (r % nb); transpose_item(p.w_up + (size_t)l * DM * DFF, p.g_ffn + l * DM, DM, DFF, WGU + (size_t)l * NGU * DM, (n0 >> 7) * 256 + 128 + (n0 & 127), scr, k0, n0, lane); continue; } r -= I_G;
        { const int nb = DM / 32, k0 = 64 * (r / nb), n0 = 32 * (r % nb); const int kh = k0 / KH; transpose_item(p.w_down + (size_t)l * DFF * DM, nullptr, DFF, DM, WDN + (size_t)l * DM * DFF, n0, scr, k0, n0, lane, (bf16_t*)(p.ws + WS_WDNS) + (size_t)(l * 2 + kh) * DM * KH, KH, k0 - kh * KH); }
    }
    {
        bf16_t* WPT = (bf16_t*)(p.ws + WS_WPT); bf16_t* WST = (bf16_t*)(p.ws + WS_WST);
        const int gt = blockIdx.x * 512 + tid, NGT = gridDim.x * 512;
        for (int e = gt; e < 2 * 4 * 64 * 64; e += NGT) { const int c = e & 63, d = (e >> 6) & 63, lg = e >> 12;
            const float v = p.w_pool[((size_t)lg * 64 + c) * 64 + d] * p.pool_scale[(lg >> 2) * 256 + (lg & 3) * 64 + d]; WPT[e] = (bf16_t)(pk_bf16(v, 0.f) & 0xffffu); }
        for (int e = gt; e < 2 * 4 * 128 * 128; e += NGT) { const int j = e & 127, i = (e >> 7) & 127; const float v = (j <= i) ? p.w_s[e] : 0.f; WST[e] = (bf16_t)(pk_bf16(v, 0.f) & 0xffffu); }
    }
    {
        float* SP = (float*)(p.ws + WS_SMALL);
        const int gt = blockIdx.x * 512 + tid, NGT = gridDim.x * 512;
        for (int e = gt; e < SP_END; e += NGT) {
            float v;
            if (e < SP_BDW) v = p.w_dw[e - SP_WDW]; else if (e < SP_LNG) v = p.b_dw[e - SP_BDW]; else if (e < SP_LNB) v = p.ln_g[e - SP_LNG]; else if (e < SP_WSC) v = p.ln_b[e - SP_LNB];
            else if (e < SP_BS) v = p.w_sconv[e - SP_WSC]; else if (e < SP_GF) v = p.b_s[e - SP_BS]; else if (e < SP_STP) v = p.g_final[e - SP_GF]; else if (e < SP_STC) v = p.st_pool[e - SP_STP];
            else if (e < SP_STS) v = p.st_conv[e - SP_STC]; else v = p.st_sc[e - SP_STS];
            SP[e] = v;
        }
    }
}

__device__ __forceinline__ void convert_rows(const Params& p, int lane, const int gw, const int NGW, const int row_lo, const int row_hi) {
    bf16_t* XB = (bf16_t*)(p.ws + WS_XB); float* SSQ = (float*)(p.ws + WS_SSQA);
    for (int m0 = row_lo + gw; m0 < row_hi; m0 += 4 * NGW) {
        f32x4 v[4][4]; float s[4];
#pragma unroll
        for (int h = 0; h < 4; ++h) { const int m = m0 + h * NGW; const int mm = m < row_hi ? m : m0;
            const float* xrow = (mm < MP) ? p.x_prompt + (size_t)mm * DM : p.x_sample + (size_t)(mm - MP) * DM; const f32x4* xr = (const f32x4*)xrow + lane;
#pragma unroll
            for (int j = 0; j < 4; ++j) v[h][j] = xr[64 * j]; }
#pragma unroll
        for (int h = 0; h < 4; ++h) { const int m = m0 + h * NGW;
            float q = 0.f;
#pragma unroll
            for (int j = 0; j < 4; ++j) q += (v[h][j][0] * v[h][j][0] + v[h][j][1] * v[h][j][1]) + (v[h][j][2] * v[h][j][2] + v[h][j][3] * v[h][j][3]);
            s[h] = wave_sum(q);
            if (m < row_hi) { u32x2* o8 = (u32x2*)(XB + (size_t)m * DM) + lane;
#pragma unroll
                for (int j = 0; j < 4; ++j) { u32x2 w; w.x = pk_bf16(v[h][j][0], v[h][j][1]); w.y = pk_bf16(v[h][j][2], v[h][j][3]); o8[64 * j] = w; }
                if (lane < 16) SSQ[(size_t)m * 16 + lane] = (lane == 0) ? s[h] : 0.f; } }
    }
}

struct Tile { int g0, R, t0, sb, b, last; };
__device__ __forceinline__ Tile prompt_tile(int q, int R) { Tile t; t.g0 = q * R; t.R = R; t.t0 = t.g0 & (SEQ - 1); t.sb = -1; t.b = t.g0 / SEQ; t.last = (t.t0 + R == SEQ); return t; }
__device__ __forceinline__ Tile sample_tile(int b) { Tile t; t.g0 = MP + b * DSQ; t.R = DSQ; t.t0 = PAST; t.sb = b; t.b = b; t.last = 1; return t; }
__device__ __forceinline__ void unpack8(const u32x4 w, float* f) { f[0] = bf_lo(w.x); f[1] = bf_hi(w.x); f[2] = bf_lo(w.y); f[3] = bf_hi(w.y); f[4] = bf_lo(w.z); f[5] = bf_hi(w.z); f[6] = bf_lo(w.w); f[7] = bf_hi(w.w); }
__device__ __forceinline__ void store8f(float* dst, const float* f) { *(f32x4*)dst = (f32x4){f[0], f[1], f[2], f[3]}; *(f32x4*)(dst + 4) = (f32x4){f[4], f[5], f[6], f[7]}; }
__device__ __forceinline__ void load8f(const float* src, float* f) { const f32x4 a = *(const f32x4*)src, b = *(const f32x4*)(src + 4); f[0] = a[0]; f[1] = a[1]; f[2] = a[2]; f[3] = a[3]; f[4] = b[0]; f[5] = b[1]; f[6] = b[2]; f[7] = b[3]; }
#define WG_BAR() do { asm volatile("s_waitcnt lgkmcnt(0)" ::: "memory"); __builtin_amdgcn_s_barrier(); asm volatile("" ::: "memory"); } while (0)

template <int H, int K>
__device__ __forceinline__ void xstep(float (&v)[16], int lane) {
    const bool up = (lane >> K) & 1;
#pragma unroll
    for (int i = 0; i < H; ++i) { const float send = up ? v[i] : v[i + H]; const float keep = up ? v[i + H] : v[i]; v[i] = keep + __shfl_xor(send, 1 << K); }
}
__device__ __forceinline__ float xreduce16(float (&v)[16], int lane) {
    xstep<8, 0>(v, lane); xstep<4, 1>(v, lane); xstep<2, 2>(v, lane); xstep<1, 3>(v, lane);
    float r = v[0]; r += __shfl_xor(r, 16); r += __shfl_xor(r, 32); return r;
}
__device__ __forceinline__ void conv_block(const LAS float* z, LAS float* st, const float (&w)[31], float bias, int r0, int c, int lane, int wq, float (&cv)[8]) {
    float win[38];
#pragma unroll
    for (int i = 0; i < 38; ++i) win[i] = z[(r0 + i) * 256 + c];
    float sv[16];
#pragma unroll
    for (int j = 0; j < 8; ++j) { float a = bias;
#pragma unroll
        for (int k = 0; k < 31; ++k) a += w[k] * win[j + k];
        asm volatile("" : "+v"(a));
        cv[j] = a; sv[2 * j] = a; sv[2 * j + 1] = a * a; }
    const float r = xreduce16(sv, lane);
    const int idx = ((lane & 1) << 3) | ((lane & 2) << 1) | ((lane & 4) >> 1) | ((lane & 8) >> 3);
    if (lane < 16) st[((r0 + (idx >> 1)) * 4 + wq) * 2 + (idx & 1)] = r;
}
__device__ __forceinline__ void conv_norm(const LAS float* st, const float (&cv)[8], int r0, float lg, float lb, bf16_t* mixrow) {
#pragma unroll
    for (int j = 0; j < 8; ++j) { const LAS float* sp = st + (r0 + j) * 8;
        const float s = (sp[0] + sp[2]) + (sp[4] + sp[6]), q = (sp[1] + sp[3]) + (sp[5] + sp[7]);
        const float mean = s * (1.0f / 256.0f); float var = q * (1.0f / 256.0f) - mean * mean; var = var < 0.f ? 0.f : var;
        const float n = (cv[j] - mean) * rsqrtf(var + EPS) * lg + lb;
        const float y = n * __builtin_amdgcn_rcpf(1.0f + __builtin_amdgcn_exp2f(n * -1.4426950408889634f));
        mixrow[(size_t)j * DM] = (bf16_t)(pk_bf16(y, 0.f) & 0xffffu); }
}
__device__ __forceinline__ void mix_conv(const Params& p, int l, const Tile t, const bf16_t* P, bf16_t* MIX, LAS unsigned char* lds, int tid) {
    LAS float* z = (LAS float*)lds;
    LAS float* st = (LAS float*)(lds + 94 * 256 * 4);
    const float* SP = (const float*)(p.ws + WS_SMALL);
    const int lane = tid & 63, wave = tid >> 6;
    const int nitems = (t.R + 30) * 32;
    const bool hist_from_p = (t.sb < 0) && (t.t0 != 0);
    float* oconv = p.out + ((t.sb < 0) ? O_CONVP + (size_t)(l * NBP + t.b) * 30 * 256 : O_CONVS + (size_t)(l * NBS + t.b) * 30 * 256);
    {
        u32x4 A[6], G[6];
#pragma unroll
        for (int i = 0; i < 6; ++i) { const int idx = tid + 512 * i, rr = idx >> 5, c8 = (idx & 31) * 8, rrel = rr - 30;
            A[i] = (u32x4){0u, 0u, 0u, 0u}; G[i] = (u32x4){0u, 0u, 0u, 0u};
            if (idx < nitems) {
                if (rrel >= 0 || hist_from_p) A[i] = *(const u32x4*)(P + (size_t)(t.g0 + rrel) * DP + PC_Z + c8);
                else if (t.sb >= 0) { const float* sp = SP + SP_STC + ((size_t)(l * NBS + t.b) * 30 + rr) * 256 + c8; A[i] = *(const u32x4*)sp; G[i] = *(const u32x4*)(sp + 4); } } }
#pragma unroll
        for (int i = 0; i < 6; ++i) { const int idx = tid + 512 * i, rr = idx >> 5, c8 = (idx & 31) * 8, rrel = rr - 30;
            if (idx < nitems) { float zz[8];
                if (rrel >= 0 || hist_from_p) unpack8(A[i], zz);
                else { zz[0] = __uint_as_float(A[i].x); zz[1] = __uint_as_float(A[i].y); zz[2] = __uint_as_float(A[i].z); zz[3] = __uint_as_float(A[i].w);
                       zz[4] = __uint_as_float(G[i].x); zz[5] = __uint_as_float(G[i].y); zz[6] = __uint_as_float(G[i].z); zz[7] = __uint_as_float(G[i].w); }
                *(LAS f32x4*)(z + rr * 256 + c8) = (f32x4){zz[0], zz[1], zz[2], zz[3]}; *(LAS f32x4*)(z + rr * 256 + c8 + 4) = (f32x4){zz[4], zz[5], zz[6], zz[7]};
                if (t.last && rrel >= t.R - 30) store8f(oconv + (size_t)(rrel - (t.R - 30)) * 256 + c8, zz); } }
    }
    const int c = tid & 255, half = tid >> 8, rph = t.R >> 1, nblk = rph >> 3;
    float w[31];
#pragma unroll
    for (int k = 0; k < 31; ++k) w[k] = SP[SP_WDW + (l * 31 + k) * 256 + c];
    const float bias = SP[SP_BDW + l * 256 + c];
    const float lg = SP[SP_LNG + l * 256 + c], lb = SP[SP_LNB + l * 256 + c];
    WG_BAR();
    float cv[4][8];
#pragma unroll
    for (int blk = 0; blk < 4; ++blk) if (blk < nblk) conv_block(z, st, w, bias, half * rph + blk * 8, c, lane, wave & 3, cv[blk]);
    WG_BAR();
#pragma unroll
    for (int blk = 0; blk < 4; ++blk) if (blk < nblk) { const int r0 = half * rph + blk * 8; conv_norm(st, cv[blk], r0, lg, lb, MIX + (size_t)(t.g0 + r0) * DM + 256 + c); }
    WG_BAR();
}

__device__ __forceinline__ void mix_pool(const Params& p, int l, const Tile t, const bf16_t* P, bf16_t* MIX, LAS unsigned char* lds, int tid) {
    LAS float* xs = (LAS float*)lds;
    LAS bf16_t* pre = (LAS bf16_t*)(lds + 79 * 256 * 4);
    const float* SP = (const float*)(p.ws + WS_SMALL);
    const int lane = tid & 63, wave = tid >> 6;
    const int nitems = (t.R + 15) * 32;
    const bool hist_from_p = (t.sb < 0) && (t.t0 != 0);
    float* opool = p.out + ((t.sb < 0) ? O_POOLP + (size_t)(l * NBP + t.b) * 15 * 256 : O_POOLS + (size_t)(l * NBS + t.b) * 15 * 256);
    {
        u32x4 A[5], B[5];
#pragma unroll
        for (int i = 0; i < 5; ++i) { const int idx = tid + 512 * i, rr = idx >> 5, c8 = (idx & 31) * 8, rrel = rr - 15;
            A[i] = (u32x4){0u, 0u, 0u, 0u}; B[i] = (u32x4){0u, 0u, 0u, 0u};
            if (idx < nitems) {
                if (rrel >= 0 || hist_from_p) A[i] = *(const u32x4*)(P + (size_t)(t.g0 + rrel) * DP + c8);
                else if (t.sb >= 0) { const float* sp = SP + SP_STP + ((size_t)(l * NBS + t.b) * 15 + rr) * 256 + c8; A[i] = *(const u32x4*)sp; B[i] = *(const u32x4*)(sp + 4); } } }
#pragma unroll
        for (int i = 0; i < 5; ++i) { const int idx = tid + 512 * i, rr = idx >> 5, c8 = (idx & 31) * 8, rrel = rr - 15;
            if (idx < nitems) { float v[8];
                if (rrel >= 0 || hist_from_p) unpack8(A[i], v);
                else { v[0] = __uint_as_float(A[i].x); v[1] = __uint_as_float(A[i].y); v[2] = __uint_as_float(A[i].z); v[3] = __uint_as_float(A[i].w);
                       v[4] = __uint_as_float(B[i].x); v[5] = __uint_as_float(B[i].y); v[6] = __uint_as_float(B[i].z); v[7] = __uint_as_float(B[i].w); }
                *(LAS f32x4*)(xs + rr * 256 + c8) = (f32x4){v[0], v[1], v[2], v[3]}; *(LAS f32x4*)(xs + rr * 256 + c8 + 4) = (f32x4){v[4], v[5], v[6], v[7]};
                if (t.last && rrel >= t.R - 15) store8f(opool + (size_t)(rrel - (t.R - 15)) * 256 + c8, v); } }
    }
    const int g = wave >> 1, rh = wave & 1, fr = lane & 15, fq = lane >> 4, rph = t.R >> 1, mt = t.R >> 5;
    bf16x8 bf[4][2];
    {
        const bf16_t* WPT = (const bf16_t*)(p.ws + WS_WPT) + (size_t)(l * 4 + g) * 64 * 64;
#pragma unroll
        for (int n = 0; n < 4; ++n)
#pragma unroll
            for (int k = 0; k < 2; ++k) bf[n][k] = *(const bf16x8*)(WPT + (16 * n + fr) * 64 + 32 * k + 8 * fq);
    }
    WG_BAR();
    {
        const int c = tid & 255, half = tid >> 8, gg = c >> 6, w = 2 << gg;
        float mk[16];
#pragma unroll
        for (int j = 0; j < 16; ++j) mk[j] = (j < w) ? 1.0f : 0.0f;
        for (int r0 = half * rph; r0 < (half + 1) * rph; r0 += 4) {
            float v[19];
#pragma unroll
            for (int i = 0; i < 19; ++i) v[i] = xs[(r0 + i) * 256 + c];
#pragma unroll
            for (int q = 0; q < 4; ++q) { float s = 0.f;
#pragma unroll
                for (int j = 0; j < 16; ++j) s += mk[j] * v[q + 15 - j];
                const int pos = t.t0 + r0 + q; const float cnt = (float)((pos + 1 < w) ? pos + 1 : w);
                const float pv = s * __builtin_amdgcn_rcpf(cnt) - v[q + 15];
                pre[(r0 + q) * 264 + c] = (bf16_t)(pk_bf16(pv, 0.f) & 0xffffu); }
        }
    }
    WG_BAR();
#pragma unroll
    for (int m = 0; m < 2; ++m) {
        if (m < mt) {
            const int row = rh * rph + 16 * m + fr;
            bf16x8 af[2];
#pragma unroll
            for (int k = 0; k < 2; ++k) af[k] = *(const LAS bf16x8*)(pre + row * 264 + g * 64 + 32 * k + 8 * fq);
#pragma unroll
            for (int n = 0; n < 4; ++n) { f32x4 a = {0.f, 0.f, 0.f, 0.f};
#pragma unroll
                for (int k = 0; k < 2; ++k) a = __builtin_amdgcn_mfma_f32_16x16x32_bf16(bf[n][k], af[k], a, 0, 0, 0);
                u32x2 o; o.x = pk_bf16(a[0], a[1]); o.y = pk_bf16(a[2], a[3]);
                *(u32x2*)(MIX + (size_t)(t.g0 + row) * DM + g * 64 + 16 * n + 4 * fq) = o; }
        }
    }
    WG_BAR();
}

__device__ __forceinline__ void mix_sconv(const Params& p, int l, const Tile t, const bf16_t* P, bf16_t* MIX, int tid) {
    const bool hist_from_p = (t.sb < 0) && (t.t0 != 0);
    const float* SP = (const float*)(p.ws + WS_SMALL);
    float* osc = p.out + ((t.sb < 0) ? O_SCP + (size_t)(l * NBP + t.b) * 2 * 256 : O_SCS + (size_t)(l * NBS + t.b) * 2 * 256);
    const int c8 = (tid & 31) * 8, r0 = (tid >> 5) * 4;
    if (r0 >= t.R) return;
    u32x4 XS[6], CG[6], BG[4];
#pragma unroll
    for (int i = 0; i < 6; ++i) { const int rrel = r0 - 2 + i; XS[i] = (u32x4){0u, 0u, 0u, 0u}; CG[i] = (u32x4){0u, 0u, 0u, 0u};
        if (rrel >= 0 || hist_from_p) XS[i] = *(const u32x4*)(P + (size_t)(t.g0 + rrel) * DP + PC_ZS + c8);
        else if (t.sb >= 0) { const float* sp = SP + SP_STS + ((size_t)(l * NBS + t.b) * 2 + (rrel + 2)) * 256 + c8; XS[i] = *(const u32x4*)sp; CG[i] = *(const u32x4*)(sp + 4); } }
#pragma unroll
    for (int i = 0; i < 4; ++i) BG[i] = *(const u32x4*)(P + (size_t)(t.g0 + r0 + i) * DP + PC_B + c8);
    float w0[8], w1[8], w2[8];
    load8f(SP + SP_WSC + (l * 3 + 0) * 256 + c8, w0); load8f(SP + SP_WSC + (l * 3 + 1) * 256 + c8, w1); load8f(SP + SP_WSC + (l * 3 + 2) * 256 + c8, w2);
    float z[6][8];
#pragma unroll
    for (int i = 0; i < 6; ++i) { const int rrel = r0 - 2 + i;
        if (rrel >= 0 || hist_from_p) unpack8(XS[i], z[i]);
        else { z[i][0] = __uint_as_float(XS[i].x); z[i][1] = __uint_as_float(XS[i].y); z[i][2] = __uint_as_float(XS[i].z); z[i][3] = __uint_as_float(XS[i].w);
               z[i][4] = __uint_as_float(CG[i].x); z[i][5] = __uint_as_float(CG[i].y); z[i][6] = __uint_as_float(CG[i].z); z[i][7] = __uint_as_float(CG[i].w); } }
#pragma unroll
    for (int i = 0; i < 4; ++i) { const int r = r0 + i; float bg[8], o[8]; unpack8(BG[i], bg);
#pragma unroll
        for (int e = 0; e < 8; ++e) o[e] = bg[e] * (w0[e] * z[i][e] + w1[e] * z[i + 1][e] + w2[e] * z[i + 2][e]);
        u32x4 w; w.x = pk_bf16(o[0], o[1]); w.y = pk_bf16(o[2], o[3]); w.z = pk_bf16(o[4], o[5]); w.w = pk_bf16(o[6], o[7]);
        *(u32x4*)(MIX + (size_t)(t.g0 + r) * DM + 512 + c8) = w;
        if (t.last && r >= t.R - 2) store8f(osc + (size_t)(r - (t.R - 2)) * 256 + c8, z[i + 2]); }
}

template <int R>
__device__ __forceinline__ void mix_mlp(const Params& p, int l, const Tile t, const bf16_t* P, bf16_t* MIX, LAS unsigned char* lds, int tid) {
    LAS unsigned* vs32 = (LAS unsigned*)lds;
    const LAS bf16_t* vs = (const LAS bf16_t*)lds;
    const int lane = tid & 63, wave = tid >> 6;
    constexpr int NIT = R * 32 / 512;
    {
        u32x4 V[NIT];
#pragma unroll
        for (int i = 0; i < NIT; ++i) { const int idx = tid + 512 * i, r = idx >> 5, c8 = (idx & 31) * 8; V[i] = *(const u32x4*)(P + (size_t)(t.g0 + r) * DP + PC_V + c8); }
#pragma unroll
        for (int i = 0; i < NIT; ++i) { const int idx = tid + 512 * i, r = idx >> 5, c8 = (idx & 31) * 8;
            LAS unsigned* d = vs32 + r * 129 + (c8 >> 1); d[0] = V[i].x; d[1] = V[i].y; d[2] = V[i].z; d[3] = V[i].w;
            if (R == 32) { float f[8]; unpack8(V[i], f); store8f(p.out + O_VS + ((size_t)(l * NBS + t.b) * 32 + r) * 256 + c8, f); } }
    }
    const int h = wave >> 1, rh = wave & 1, fr = lane & 15, fq = lane >> 4;
    constexpr int MMAX = (R == 128) ? 4 : 2, KMAX = (R == 128) ? 4 : 1;
    const int kmax = (R == 128) ? 2 * (rh + 1) : 1;
    const bool active = (R == 128 || rh == 0);
    bf16x8 af[KMAX][MMAX]; u32x2 uu[MMAX][4]; float bias[MMAX];
    if (active) {
        const bf16_t* WST = (const bf16_t*)(p.ws + WS_WST) + (size_t)(l * 4 + h) * 128 * 128;
#pragma unroll
        for (int k = 0; k < KMAX; ++k)
#pragma unroll
            for (int m = 0; m < MMAX; ++m) af[k][m] = (k < kmax) ? *(const bf16x8*)(WST + (size_t)(64 * rh + 16 * m + fr) * 128 + 32 * k + 8 * fq) : (bf16x8){0, 0, 0, 0, 0, 0, 0, 0};
#pragma unroll
        for (int m = 0; m < MMAX; ++m) { const int i = 64 * rh + 16 * m + fr; bias[m] = ((const float*)(p.ws + WS_SMALL))[SP_BS + (l * 4 + h) * 128 + i];
#pragma unroll
            for (int n = 0; n < 4; ++n) uu[m][n] = *(const u32x2*)(P + (size_t)(t.g0 + i) * DP + PC_U + 64 * h + 16 * n + 4 * fq); }
    }
    WG_BAR();
    if (active) {
        f32x4 acc[MMAX][4];
#pragma unroll
        for (int m = 0; m < MMAX; ++m)
#pragma unroll
            for (int n = 0; n < 4; ++n) acc[m][n] = (f32x4){0.f, 0.f, 0.f, 0.f};
#pragma unroll
        for (int k = 0; k < KMAX; ++k) {
            if (k < kmax) {
                bf16x8 bf[4];
#pragma unroll
                for (int n = 0; n < 4; ++n)
#pragma unroll
                    for (int i = 0; i < 8; ++i) bf[n][i] = (short)vs[(32 * k + 8 * fq + i) * 258 + 64 * h + 16 * n + fr];
#pragma unroll
                for (int m = 0; m < MMAX; ++m)
#pragma unroll
                    for (int n = 0; n < 4; ++n) acc[m][n] = __builtin_amdgcn_mfma_f32_16x16x32_bf16(bf[n], af[k][m], acc[m][n], 0, 0, 0);
            }
        }
#pragma unroll
        for (int m = 0; m < MMAX; ++m) {
            const int i = 64 * rh + 16 * m + fr;
#pragma unroll
            for (int n = 0; n < 4; ++n) { const int d = 64 * h + 16 * n + 4 * fq;
                const float o0 = bf_lo(uu[m][n].x) * (acc[m][n][0] + bias[m]), o1 = bf_hi(uu[m][n].x) * (acc[m][n][1] + bias[m]), o2 = bf_lo(uu[m][n].y) * (acc[m][n][2] + bias[m]), o3 = bf_hi(uu[m][n].y) * (acc[m][n][3] + bias[m]);
                u32x2 o; o.x = pk_bf16(o0, o1); o.y = pk_bf16(o2, o3);
                *(u32x2*)(MIX + (size_t)(t.g0 + i) * DM + 768 + d) = o; }
        }
    }
    WG_BAR();
}


__device__ __forceinline__ void conv_loads(const Tile t, const bf16_t* P, int tid, u32x4 (&A)[6]) {
    const bool hist = (t.t0 != 0);
#pragma unroll
    for (int i = 0; i < 6; ++i) { const int idx = tid + 512 * i, rr = idx >> 5, c8 = (idx & 31) * 8, rrel = rr - 30;
        A[i] = (u32x4){0u, 0u, 0u, 0u};
        if (idx < 94 * 32 && (rrel >= 0 || hist)) A[i] = *(const u32x4*)(P + (size_t)(t.g0 + rrel) * DP + PC_Z + c8); }
}
__device__ __forceinline__ int mix_conv_run(const Params& p, int l, const bf16_t* P, bf16_t* MIX, LAS unsigned char* lds, int tid, int u, const int stride, const int uend) {
    LAS float* z = (LAS float*)lds; LAS float* st = (LAS float*)(lds + 94 * 256 * 4);
    const float* SP = (const float*)(p.ws + WS_SMALL);
    const int lane = tid & 63, wave = tid >> 6, c = tid & 255, half = tid >> 8;
    float w[31];
#pragma unroll
    for (int k = 0; k < 31; ++k) w[k] = SP[SP_WDW + (l * 31 + k) * 256 + c];
    const float bias = SP[SP_BDW + l * 256 + c], lg = SP[SP_LNG + l * 256 + c], lb = SP[SP_LNB + l * 256 + c];
    Tile t = prompt_tile(u, 64);
    u32x4 A[6]; conv_loads(t, P, tid, A);
    for (;;) {
        float* oconv = p.out + O_CONVP + (size_t)(l * NBP + t.b) * 30 * 256;
#pragma unroll
        for (int i = 0; i < 6; ++i) { const int idx = tid + 512 * i, rr = idx >> 5, c8 = (idx & 31) * 8, rrel = rr - 30;
            if (idx < 94 * 32) { float zz[8]; unpack8(A[i], zz);
                *(LAS f32x4*)(z + rr * 256 + c8) = (f32x4){zz[0], zz[1], zz[2], zz[3]}; *(LAS f32x4*)(z + rr * 256 + c8 + 4) = (f32x4){zz[4], zz[5], zz[6], zz[7]};
                if (t.last && rrel >= 34) store8f(oconv + (size_t)(rrel - 34) * 256 + c8, zz); } }
        WG_BAR();
        const int un = u + stride; const bool hn = un < uend; const Tile tn = prompt_tile(hn ? un : u, 64);
        if (hn) conv_loads(tn, P, tid, A);
        float cv[4][8];
#pragma unroll
        for (int blk = 0; blk < 4; ++blk) conv_block(z, st, w, bias, half * 32 + blk * 8, c, lane, wave & 3, cv[blk]);
        WG_BAR();
#pragma unroll
        for (int blk = 0; blk < 4; ++blk) { const int r0 = half * 32 + blk * 8; conv_norm(st, cv[blk], r0, lg, lb, MIX + (size_t)(t.g0 + r0) * DM + 256 + c); }
        WG_BAR();
        u = un; if (!hn) break; t = tn;
    }
    return u;
}
__device__ __forceinline__ void pool_loads(const Tile t, const bf16_t* P, int tid, u32x4 (&A)[5]) {
    const bool hist = (t.t0 != 0);
#pragma unroll
    for (int i = 0; i < 5; ++i) { const int idx = tid + 512 * i, rr = idx >> 5, c8 = (idx & 31) * 8, rrel = rr - 15;
        A[i] = (u32x4){0u, 0u, 0u, 0u};
        if (idx < 79 * 32 && (rrel >= 0 || hist)) A[i] = *(const u32x4*)(P + (size_t)(t.g0 + rrel) * DP + c8); }
}
__device__ __forceinline__ int mix_pool_run(const Params& p, int l, const bf16_t* P, bf16_t* MIX, LAS unsigned char* lds, int tid, int u, const int stride, const int uend) {
    LAS float* xs = (LAS float*)lds; LAS bf16_t* pre = (LAS bf16_t*)(lds + 79 * 256 * 4);
    const int lane = tid & 63, wave = tid >> 6, g = wave >> 1, rh = wave & 1, fr = lane & 15, fq = lane >> 4;
    bf16x8 bf[4][2];
    {
        const bf16_t* WPT = (const bf16_t*)(p.ws + WS_WPT) + (size_t)(l * 4 + g) * 64 * 64;
#pragma unroll
        for (int n = 0; n < 4; ++n)
#pragma unroll
            for (int k = 0; k < 2; ++k) bf[n][k] = *(const bf16x8*)(WPT + (16 * n + fr) * 64 + 32 * k + 8 * fq);
    }
    const int c = tid & 255, half = tid >> 8, gg = c >> 6, w = 2 << gg;
    float mk[16];
#pragma unroll
    for (int j = 0; j < 16; ++j) mk[j] = (j < w) ? 1.0f : 0.0f;
    Tile t = prompt_tile(u, 64);
    u32x4 A[5]; pool_loads(t, P, tid, A);
    for (;;) {
        float* opool = p.out + O_POOLP + (size_t)(l * NBP + t.b) * 15 * 256;
#pragma unroll
        for (int i = 0; i < 5; ++i) { const int idx = tid + 512 * i, rr = idx >> 5, c8 = (idx & 31) * 8, rrel = rr - 15;
            if (idx < 79 * 32) { float v[8]; unpack8(A[i], v);
                *(LAS f32x4*)(xs + rr * 256 + c8) = (f32x4){v[0], v[1], v[2], v[3]}; *(LAS f32x4*)(xs + rr * 256 + c8 + 4) = (f32x4){v[4], v[5], v[6], v[7]};
                if (t.last && rrel >= 49) store8f(opool + (size_t)(rrel - 49) * 256 + c8, v); } }
        WG_BAR();
        const int un = u + stride; const bool hn = un < uend; const Tile tn = prompt_tile(hn ? un : u, 64);
        if (hn) pool_loads(tn, P, tid, A);
        for (int r0 = half * 32; r0 < (half + 1) * 32; r0 += 4) {
            float v[19];
#pragma unroll
            for (int i = 0; i < 19; ++i) v[i] = xs[(r0 + i) * 256 + c];
#pragma unroll
            for (int q = 0; q < 4; ++q) { float sm = 0.f;
#pragma unroll
                for (int j = 0; j < 16; ++j) sm += mk[j] * v[q + 15 - j];
                const int pos = t.t0 + r0 + q; const float cnt = (float)((pos + 1 < w) ? pos + 1 : w);
                const float pv = sm * __builtin_amdgcn_rcpf(cnt) - v[q + 15];
                pre[(r0 + q) * 264 + c] = (bf16_t)(pk_bf16(pv, 0.f) & 0xffffu); }
        }
        WG_BAR();
#pragma unroll
        for (int m = 0; m < 2; ++m) {
            const int row = rh * 32 + 16 * m + fr;
            bf16x8 af[2];
#pragma unroll
            for (int k = 0; k < 2; ++k) af[k] = *(const LAS bf16x8*)(pre + row * 264 + g * 64 + 32 * k + 8 * fq);
#pragma unroll
            for (int n = 0; n < 4; ++n) { f32x4 a = {0.f, 0.f, 0.f, 0.f};
#pragma unroll
                for (int k = 0; k < 2; ++k) a = __builtin_amdgcn_mfma_f32_16x16x32_bf16(bf[n][k], af[k], a, 0, 0, 0);
                u32x2 o; o.x = pk_bf16(a[0], a[1]); o.y = pk_bf16(a[2], a[3]);
                *(u32x2*)(MIX + (size_t)(t.g0 + row) * DM + g * 64 + 16 * n + 4 * fq) = o; }
        }
        WG_BAR();
        u = un; if (!hn) break; t = tn;
    }
    return u;
}

constexpr int NU_CONV = MP / 64, NU_POOL = MP / 64, NU_MLP = MP / 128, NU_SC = MP / 64, NU_PROMPT = NU_CONV + NU_POOL + NU_MLP + NU_SC, NU_ALL = NU_PROMPT + 4 * NBS;
__device__ __forceinline__ void mixer_phase(const Params& p, int l, LAS unsigned char* lds, int tid, const int first, const int stride, const int mask = EXP_MIXMASK) {
    const bf16_t* P = (const bf16_t*)(p.ws + WS_P); bf16_t* MIX = (bf16_t*)(p.ws + WS_MIX);
    int u = first;
    asm volatile("" : "+v"(tid));
    if (u < NU_CONV) { const int un = mix_conv_run(p, l, P, MIX, lds, tid, u, stride, NU_CONV); u = un; }
    asm volatile("" : "+v"(tid));
    if (u < NU_CONV + NU_POOL) { const int un = mix_pool_run(p, l, P, MIX, lds, tid, u - NU_CONV, stride, NU_POOL); u = un + NU_CONV; }
    for (; u < NU_PROMPT; u += stride) {
        int r = u - NU_CONV - NU_POOL; asm volatile("" : "+v"(tid));
        {
            const int rn = r + stride;
            if (rn < NU_MLP) { const Tile tn = prompt_tile(rn, 128); const bf16_t* q = P + (size_t)(tn.g0 + (tid >> 2)) * DP + 64 * (tid & 3);
                (void)*(volatile const unsigned*)(q + PC_V); (void)*(volatile const unsigned*)(q + PC_U); }
            else if (rn < NU_MLP + NU_SC) { const Tile tn = prompt_tile(rn - NU_MLP, 64); const int rr = (tid >> 2) - 2;
                if (rr < 64 && (rr >= 0 || tn.t0 != 0)) (void)*(volatile const unsigned*)(P + (size_t)(tn.g0 + rr) * DP + PC_ZS + 64 * (tid & 3));
                if (rr >= 0 && rr < 64) (void)*(volatile const unsigned*)(P + (size_t)(tn.g0 + rr) * DP + PC_B + 64 * (tid & 3)); }
        }
        if (r < NU_MLP) { if (mask & 4) mix_mlp<128>(p, l, prompt_tile(r, 128), P, MIX, lds, tid); continue; } r -= NU_MLP;
        if (mask & 8) mix_sconv(p, l, prompt_tile(r, 64), P, MIX, tid);
    }
}
__device__ __forceinline__ void sample_mixers(const Params& p, int l, LAS unsigned char* lds, int tid, const int first, const int stride) {
    const bf16_t* P = (const bf16_t*)(p.ws + WS_P); bf16_t* MIX = (bf16_t*)(p.ws + WS_MIX);
    for (int r = first; r < 4 * NBS; r += stride) {
        asm volatile("" : "+v"(tid));
        const int b = r & 7, kind = r >> 3;
        if (kind == 0) mix_conv(p, l, sample_tile(b), P, MIX, lds, tid);
        else if (kind == 1) mix_pool(p, l, sample_tile(b), P, MIX, lds, tid);
        else if (kind == 2) mix_mlp<32>(p, l, sample_tile(b), P, MIX, lds, tid);
        else mix_sconv(p, l, sample_tile(b), P, MIX, tid);
    }
}

__device__ __forceinline__ void final_norm(const Params& p, int lane, int wave, const int gw, const int NGW, const int row_lo, const int row_hi) {
    const bf16_t* XB = (const bf16_t*)(p.ws + WS_XB); const float* SSQ = (const float*)(p.ws + WS_SSQA);
    f32x4 g[4];
#pragma unroll
    for (int j = 0; j < 4; ++j) g[j] = ((const f32x4*)(p.ws + WS_SMALL + (size_t)SP_GF * 4))[lane + 64 * j];
    for (int m0 = row_lo + gw; m0 < row_hi; m0 += 4 * NGW) {
        u32x2 v[4][4]; float s[4];
#pragma unroll
        for (int h = 0; h < 4; ++h) { const int m = m0 + h * NGW; const int mm = m < row_hi ? m : m0; const u32x2* xr = (const u32x2*)(XB + (size_t)mm * DM) + lane;
#pragma unroll
            for (int j = 0; j < 4; ++j) v[h][j] = xr[64 * j];
            s[h] = (lane < 16) ? SSQ[(size_t)mm * 16 + lane] : 0.f; }
#pragma unroll
        for (int h = 0; h < 4; ++h) { const int m = m0 + h * NGW; const float rs = rsqrtf(wave_sum(s[h]) * (1.0f / DM) + EPS);
            if (m < row_hi) { f32x4* o = (f32x4*)(p.out + (size_t)m * DM) + lane;
#pragma unroll
                for (int j = 0; j < 4; ++j) { const f32x4 x = {bf_lo(v[h][j].x), bf_hi(v[h][j].x), bf_lo(v[h][j].y), bf_hi(v[h][j].y)}; __builtin_nontemporal_store(x * rs * g[j], &o[64 * j]); } } }
    }
}

#define XB_TMO      128
#define XB_XCNT(j)  (256  + 64 * (j))
#define XB_XSUB(j)  (1280 + 64 * (j))
#define XB_XGEN(j)  (2304 + 64 * (j))
#define XB_TOP      3328
#define XB_TOPGEN   3392
#define XCD_BAR_WORDS 3456
#define XB_SPIN_CAP (1u << 18)

__device__ __forceinline__ unsigned xb_ld(unsigned* p)              { return __hip_atomic_load(p, __ATOMIC_RELAXED, __HIP_MEMORY_SCOPE_AGENT); }
__device__ __forceinline__ unsigned xb_add(unsigned* p, unsigned v) { return __hip_atomic_fetch_add(p, v, __ATOMIC_RELAXED, __HIP_MEMORY_SCOPE_AGENT); }
__device__ __forceinline__ unsigned xb_xcc_id() { return (unsigned)__builtin_amdgcn_s_getreg((3 << 11) | 20) & 0xFu; }
#define XB_SPIN(cond, bar) do { unsigned _sp = 0; while (cond) { __builtin_amdgcn_s_sleep(1); \
    if ((++_sp & 255u) == 0u) { if (xb_ld(&(bar)[XB_TMO])) break; if (_sp > XB_SPIN_CAP) { atomicAdd(&(bar)[XB_TMO], 1u); break; } } } } while (0)

struct XcdBarrier {
    unsigned* bar; unsigned x;
    volatile LAS unsigned* st;
};

__device__ __forceinline__ XcdBarrier xcd_barrier_post(unsigned* bar, volatile LAS unsigned* st) {
    XcdBarrier b; b.bar = bar; b.x = xb_xcc_id(); b.st = st;
    if (threadIdx.x == 0) (void)xb_add(&bar[XB_XCNT(b.x)], 1u);
    return b;
}
__device__ __forceinline__ void xcd_barrier_complete(unsigned* bar, unsigned x, unsigned& nloc, unsigned& nx) {
    const unsigned G = gridDim.x * gridDim.y * gridDim.z;
    unsigned sum, cnt, mine, sp = 0u;
    for (;;) {
        sum = 0u; cnt = 0u; mine = 0u;
#pragma unroll
        for (unsigned j = 0; j < 16; ++j) { const unsigned c = xb_ld(&bar[XB_XCNT(j)]); sum += c; cnt += (c > 0u) ? 1u : 0u; mine = (j == x) ? c : mine; }
        if (sum == G) break;
        __builtin_amdgcn_s_sleep(1);
        if ((++sp & 255u) == 0u) { if (xb_ld(&bar[XB_TMO])) break; if (sp > XB_SPIN_CAP) { atomicAdd(&bar[XB_TMO], 1u); break; } }
    }
    nloc = mine > 0u ? mine : 1u; nx = cnt > 0u ? cnt : 1u;
}

__device__ __forceinline__ void xcd_barrier(const XcdBarrier& b) {
    asm volatile("s_waitcnt vmcnt(0)" ::: "memory");
    __syncthreads();
    if (pg8::pg8_tid((LAS unsigned char*)b.st - 131072) == 0) {
        unsigned* bar = b.bar;
        __builtin_amdgcn_s_waitcnt(0);
        unsigned nloc = b.st[0], nx = b.st[1];
        if (nloc == 0u) { xcd_barrier_complete(bar, b.x, nloc, nx); b.st[0] = nloc; b.st[1] = nx; }
        const unsigned old = xb_add(&bar[XB_XSUB(b.x)], 1u);
        const unsigned gen = old / nloc;
        if (old + 1u == (gen + 1u) * nloc) {
            __builtin_amdgcn_fence(__ATOMIC_RELEASE, "agent");
            asm volatile("s_waitcnt vmcnt(0)" ::: "memory");
            const unsigned og = xb_add(&bar[XB_TOP], 1u);
            const unsigned tg = og / nx;
            if (og + 1u == (tg + 1u) * nx) xb_add(&bar[XB_TOPGEN], 1u);
            else XB_SPIN(xb_ld(&bar[XB_TOPGEN]) == tg, bar);
            __builtin_amdgcn_fence(__ATOMIC_ACQUIRE, "agent");
            xb_add(&bar[XB_XGEN(b.x)], 1u);
            asm volatile("s_waitcnt vmcnt(0)" ::: "memory");
        } else {
            XB_SPIN(xb_ld(&bar[XB_XGEN(b.x)]) == gen, bar);
            __builtin_amdgcn_fence(__ATOMIC_ACQUIRE, "agent");
            asm volatile("s_waitcnt vmcnt(0)" ::: "memory");
        }
    }
    __syncthreads();
}


constexpr int NSG = 22;
struct SampleOrder {
    int nN, c;
    __device__ __forceinline__ bool next(int i, pg8::Unit& u) const { const int j = i * NSG + c; if (j >= nN) return false; u.pm = MP / 256; u.pn = j; return true; }
    __device__ __forceinline__ void a_ready(const pg8::Unit&) const {}
    __device__ __forceinline__ void done(const pg8::Unit&) const {}
};
__device__ __forceinline__ void group_barrier(unsigned* ctr, unsigned target, unsigned* tmo, int tid) {
    asm volatile("s_waitcnt vmcnt(0)" ::: "memory");
    __syncthreads();
    if (tid == 0) {
        __builtin_amdgcn_fence(__ATOMIC_RELEASE, "agent");
        asm volatile("s_waitcnt vmcnt(0)" ::: "memory");
        (void)__hip_atomic_fetch_add(ctr, 1u, __ATOMIC_RELAXED, __HIP_MEMORY_SCOPE_AGENT);
        unsigned sp = 0;
        while (__hip_atomic_load(ctr, __ATOMIC_RELAXED, __HIP_MEMORY_SCOPE_AGENT) < target) { __builtin_amdgcn_s_sleep(1);
            if ((++sp & 255u) == 0u) { if (__hip_atomic_load(tmo, __ATOMIC_RELAXED, __HIP_MEMORY_SCOPE_AGENT)) break; if (sp > (1u << 20)) { atomicAdd(tmo, 1u); break; } } }
        __builtin_amdgcn_fence(__ATOMIC_ACQUIRE, "agent");
        asm volatile("s_waitcnt vmcnt(0)" ::: "memory");
    }
    __syncthreads();
}


struct EpiSwiGLUS {
    static constexpr bool PERM = true, AFTER_DRAIN = false;
    bf16_t* H; const float* ssq;
    __device__ __forceinline__ void operator()(const f32x4 (&acc)[2][2][4][2], const pg8::Unit& u, int wr, int wc, int fr, int fq) const {
        asm volatile("" : "+v"(fr));
        const int row0 = u.pm * 256 + wr * 64 + fr, lrow0 = wr * 64 + fr, kh = u.pn / 11, col0 = (u.pn - 11 * kh) * 128 + wc * 32 + 8 * fq;
        bf16_t* Hh = H + (size_t)kh * MS * KH;
#pragma unroll
        for (int ai = 0; ai < 2; ++ai)
#pragma unroll
            for (int m = 0; m < 4; ++m) {
                const int row = row0 + ai * 128 + m * 16; const float rs = row_rstd(ssq, row, fq);
                float h[8];
                const float c1 = rs * -1.4426950408889634f, rs2 = rs * rs;
#pragma unroll
                for (int n = 0; n < 2; ++n)
#pragma unroll
                    for (int j = 0; j < 4; j += 2) { const f32x2 ag = {acc[ai][0][m][n][j], acc[ai][0][m][n][j + 1]}, au = {acc[ai][1][m][n][j], acc[ai][1][m][n][j + 1]};
                        const f32x2 t = ag * c1; f32x2 e; e.x = __builtin_amdgcn_exp2f(t.x); e.y = __builtin_amdgcn_exp2f(t.y);
                        const f32x2 d = e + 1.0f; f32x2 r; r.x = __builtin_amdgcn_rcpf(d.x); r.y = __builtin_amdgcn_rcpf(d.y);
                        const f32x2 hh = (ag * au) * (r * rs2); h[n * 4 + j] = hh.x; h[n * 4 + j + 1] = hh.y; }
                u32x4 w; w.x = pk_bf16(h[0], h[1]); w.y = pk_bf16(h[2], h[3]); w.z = pk_bf16(h[4], h[5]); w.w = pk_bf16(h[6], h[7]);
                *(u32x4*)(Hh + (size_t)(lrow0 + ai * 128 + m * 16) * KH + col0) = w;
            }
    }
};
struct EpiPart {
    static constexpr bool PERM = false, AFTER_DRAIN = false;
    float* part;
    __device__ __forceinline__ void operator()(const f32x4 (&acc)[2][2][4][2], const pg8::Unit& u, int wr, int wc, int fr, int fq) const {
        asm volatile("" : "+v"(fr));
        const int lrow0 = wr * 64 + fr, col0 = u.pn * 256 + wc * 32 + 4 * fq;
#pragma unroll
        for (int ai = 0; ai < 2; ++ai)
#pragma unroll
            for (int m = 0; m < 4; ++m)
#pragma unroll
                for (int bj = 0; bj < 2; ++bj)
#pragma unroll
                    for (int n = 0; n < 2; ++n) *(f32x4*)(part + (size_t)(lrow0 + ai * 128 + m * 16) * DM + col0 + bj * 128 + n * 16) = acc[ai][bj][m][n];
    }
};
struct SampleOrderD {
    int c;
    __device__ __forceinline__ bool next(int i, pg8::Unit& u) const { if (i > 0 || c >= 8) return false; u.pm = 0; u.pn = c & 3; return true; }
    __device__ __forceinline__ void a_ready(const pg8::Unit&) const {}
    __device__ __forceinline__ void done(const pg8::Unit&) const {}
};
__device__ __forceinline__ void sample_combine(const Params& p, int lane, int gw, int NGW, float* ssq) {
    bf16_t* XB = (bf16_t*)(p.ws + WS_XB) + (size_t)MP * DM; const float* P0 = (const float*)(p.ws + WS_PART); const float* P1 = P0 + (size_t)MS * DM;
    for (int r = gw; r < MS; r += NGW) {
        u32x2* xr = (u32x2*)(XB + (size_t)r * DM) + lane; const f32x4* a = (const f32x4*)(P0 + (size_t)r * DM) + lane; const f32x4* b = (const f32x4*)(P1 + (size_t)r * DM) + lane;
        float q = 0.f;
#pragma unroll
        for (int j = 0; j < 4; ++j) { const u32x2 w = xr[64 * j]; const f32x4 x = (f32x4){bf_lo(w.x), bf_hi(w.x), bf_lo(w.y), bf_hi(w.y)} + a[64 * j] + b[64 * j];
            q += (x[0] * x[0] + x[1] * x[1]) + (x[2] * x[2] + x[3] * x[3]); u32x2 o; o.x = pk_bf16(x[0], x[1]); o.y = pk_bf16(x[2], x[3]); xr[64 * j] = o; }
        q = wave_sum(q);
        if (lane < 16) ssq[(size_t)(MP + r) * 16 + lane] = (lane == 0) ? q : 0.f;
    }
}


__global__ void __launch_bounds__(512, 2) fwd_megakernel(Params p) {
    extern __shared__ __attribute__((aligned(16))) unsigned char lds_raw[];
    LAS unsigned char* lds = (LAS unsigned char*)lds_raw;
    const int G = gridDim.x, bx = blockIdx.x;
#define MYTID() pg8::pg8_tid(lds)
#define LWS(name) size_t name##_z = 0; asm volatile("" : "+s"(name##_z)); unsigned char* name = p.ws + name##_z
#define SAMPLE_DOWN(L) do { \
            { LWS(ws); const int kh = (bx >> 2) & 1; \
              pg8::Gemm g{(const bf16_t*)(ws + WS_HIDS) + (size_t)kh * MS * KH, (const bf16_t*)(ws + WS_WDNS) + (size_t)((L) * 2 + kh) * DM * KH, MS, DM, KH}; SampleOrderD S{bx}; \
              EpiPart E{(float*)(ws + WS_PART) + (size_t)kh * MS * DM}; pg8::gemm_phase<EpiPart, SampleOrderD, true, true>(lds, g, S, E); } \
            { LWS(ws); group_barrier((unsigned*)(ws + WS_CTL) + 3584, NSG * (++ep), (unsigned*)(ws + WS_CTL) + 3648, MYTID()); } \
            { LWS(ws); const int t_ = MYTID(); sample_combine(p, t_ & 63, bx * 8 + (t_ >> 6), NSG * 8, (float*)(ws + WS_SSQA)); } } while (0)
#define GRID_SYNC() do { XcdBarrier b_ = bar; asm volatile("" : "+s"(b_.x)); LWS(w_); b_.bar = (unsigned*)(w_ + WS_CTL); xcd_barrier(b_); } while (0)
    { const int tid0 = threadIdx.x; volatile LAS unsigned* stw = (volatile LAS unsigned*)(lds + 131072); if (tid0 < 64) stw[tid0] = 0u;
      if ((tid0 & 63) == 0) ((volatile LAS int*)(lds + 131072 + 256))[(int)__builtin_amdgcn_s_getreg((5 << 11) | 4) & 63] = tid0 >> 6; }
    __syncthreads();
    XcdBarrier bar = xcd_barrier_post((unsigned*)(p.ws + WS_CTL), (volatile LAS unsigned*)(lds + 131072));
    cg::this_grid().sync();
    { const int t_ = MYTID(); prologue(p, lds, t_, t_ & 63, t_ >> 6); convert_rows(p, t_ & 63, bx * 8 + (t_ >> 6), G * 8, MP, MT); }
    GRID_SYNC();
    constexpr int NI0 = DIN / 256;
    if (bx >= NI0) { int t_ = MYTID(); asm volatile("" : "+v"(t_)); convert_rows(p, t_ & 63, (bx - NI0) * 8 + (t_ >> 6), (G - NI0) * 8, 0, MP); }
    else { LWS(ws); pg8::Gemm g{(const bf16_t*)(ws + WS_XB), (const bf16_t*)(ws + WS_WIN), MT, DIN, DM}; SampleOrder S{DIN / 256, bx}; EpiInProj E{(bf16_t*)(ws + WS_P), (const float*)(ws + WS_SSQA)};
      pg8::gemm_phase<EpiInProj, SampleOrder, true, true>(lds, g, S, E); }
    GRID_SYNC();
#pragma unroll 1
    for (int l = 0; l < 2; ++l) {
        {
            LWS(ws);
            pg8::Gemm g{(const bf16_t*)(ws + WS_XB), (const bf16_t*)(ws + WS_WIN) + (size_t)l * DIN * DM, MP, DIN, DM}; pg8::StaticOrder S; S.init(MP, DIN, G, bx);
            EpiInProj E{(bf16_t*)(ws + WS_P), (const float*)(ws + WS_SSQA)};
            pg8::gemm_phase<EpiInProj, pg8::StaticOrder, true, true>(lds, g, S, E);
        }
        GRID_SYNC();
        if (bx >= NSG) mixer_phase(p, l, lds, MYTID(), bx - NSG, G - NSG);
        else {
            unsigned ep = 4u * (unsigned)l;
            if (l == 1) {
              { LWS(ws); pg8::Gemm g{(const bf16_t*)(ws + WS_XB), (const bf16_t*)(ws + WS_WIN) + (size_t)DIN * DM, MT, DIN, DM}; SampleOrder S{DIN / 256, bx}; EpiInProj E{(bf16_t*)(ws + WS_P), (const float*)(ws + WS_SSQA)};
                pg8::gemm_phase<EpiInProj, SampleOrder, true, true>(lds, g, S, E); }
              { LWS(ws); group_barrier((unsigned*)(ws + WS_CTL) + 3584, NSG * (++ep), (unsigned*)(ws + WS_CTL) + 3648, MYTID()); }
            }
            sample_mixers(p, l, lds, MYTID(), bx, NSG);
            { LWS(ws); group_barrier((unsigned*)(ws + WS_CTL) + 3584, NSG * (++ep), (unsigned*)(ws + WS_CTL) + 3648, MYTID()); }
            { LWS(ws); pg8::Gemm g{(const bf16_t*)(ws + WS_MIX), (const bf16_t*)(ws + WS_WOUT) + (size_t)l * DM * DM, MT, DM, DM}; SampleOrder S{DM / 256, bx};
              EpiResid E{nullptr, (bf16_t*)(ws + WS_XB), (float*)(ws + WS_SSQB)}; pg8::gemm_phase<EpiResid, SampleOrder, true, true>(lds, g, S, E); }
            { LWS(ws); group_barrier((unsigned*)(ws + WS_CTL) + 3584, NSG * (++ep), (unsigned*)(ws + WS_CTL) + 3648, MYTID()); }
            { LWS(ws); pg8::Gemm g{(const bf16_t*)(ws + WS_XB), (const bf16_t*)(ws + WS_WGU) + (size_t)l * NGU * DM, MT, NGU, DM}; SampleOrder S{NGU / 256, bx};
              EpiSwiGLUS E{(bf16_t*)(ws + WS_HIDS), (const float*)(ws + WS_SSQB)}; pg8::gemm_phase<EpiSwiGLUS, SampleOrder, true, true>(lds, g, S, E); }
            if (l == 0) {
                { LWS(ws); group_barrier((unsigned*)(ws + WS_CTL) + 3584, NSG * (++ep), (unsigned*)(ws + WS_CTL) + 3648, MYTID()); }
                SAMPLE_DOWN(0);
            }
        }
        GRID_SYNC();
        {
            LWS(ws);
            pg8::Gemm g{(const bf16_t*)(ws + WS_MIX), (const bf16_t*)(ws + WS_WOUT) + (size_t)l * DM * DM, MP, DM, DM}; pg8::StaticOrder S; S.init(MP, DM, G, bx);
            EpiResid E{nullptr, (bf16_t*)(ws + WS_XB), (float*)(ws + WS_SSQB)};
            pg8::gemm_phase<EpiResid, pg8::StaticOrder, true, true>(lds, g, S, E);
        }
        GRID_SYNC();
        {
            LWS(ws);
            pg8::Gemm g{(const bf16_t*)(ws + WS_XB), (const bf16_t*)(ws + WS_WGU) + (size_t)l * NGU * DM, MP, NGU, DM}; pg8::StaticOrder S; S.init(MP, NGU, G, bx);
            EpiSwiGLU E{(bf16_t*)(ws + WS_HID), (const float*)(ws + WS_SSQB)};
            pg8::gemm_phase<EpiSwiGLU, pg8::StaticOrder, true, true>(lds, g, S, E);
        }
        GRID_SYNC();
        {
            LWS(ws);
            pg8::Gemm g{(const bf16_t*)(ws + WS_HID), (const bf16_t*)(ws + WS_WDN) + (size_t)l * DM * DFF, MP, DM, DFF}; pg8::StaticOrder S; S.init(MP, DM, G, bx);
            EpiResid E{nullptr, (bf16_t*)(ws + WS_XB), (float*)(ws + WS_SSQA)};
            pg8::gemm_phase<EpiResid, pg8::StaticOrder, true, true>(lds, g, S, E);
        }
        GRID_SYNC();
    }
    if (bx >= NSG) { int t2 = MYTID(); asm volatile("" : "+v"(t2)); final_norm(p, t2 & 63, t2 >> 6, (bx - NSG) * 8 + (t2 >> 6), (G - NSG) * 8, 0, MP); }
    else {
        unsigned ep = 7u;
        SAMPLE_DOWN(1);
        { LWS(ws); group_barrier((unsigned*)(ws + WS_CTL) + 3584, NSG * (++ep), (unsigned*)(ws + WS_CTL) + 3648, MYTID()); }
        { int t2 = MYTID(); asm volatile("" : "+v"(t2)); final_norm(p, t2 & 63, t2 >> 6, bx * 8 + (t2 >> 6), NSG * 8, MP, MT); }
    }
}

extern "C" void kernel_launch(void* const* d_in, const int* in_sizes, int n_in, void* d_out, int out_size, void* d_ws, size_t ws_size, hipStream_t stream) {
    static int grid = 0;
    if (grid == 0) {
        if ((size_t)out_size != O_END) fprintf(stderr, "kernel_launch: note: out_size %d, expected %zu\n", out_size, (size_t)O_END);
        if (n_in != 22 || in_sizes[0] != MP * DM || ws_size < WS_END) {
            fprintf(stderr, "kernel_launch: unexpected shapes: n_in %d in0 %d out %d ws %zu (need %zu)\n", n_in, n_in > 0 ? in_sizes[0] : -1, out_size, ws_size, (size_t)WS_END); grid = -1; return; }
        int dev = 0, cus = 0, per_cu = 0;
        (void)hipGetDevice(&dev); (void)hipDeviceGetAttribute(&cus, hipDeviceAttributeMultiprocessorCount, dev);
        if (hipFuncSetAttribute((const void*)fwd_megakernel, hipFuncAttributeMaxDynamicSharedMemorySize, LDS_BYTES) != hipSuccess) { fprintf(stderr, "kernel_launch: hipFuncSetAttribute failed\n"); grid = -1; return; }
        if (hipOccupancyMaxActiveBlocksPerMultiprocessor(&per_cu, (const void*)fwd_megakernel, 512, LDS_BYTES) != hipSuccess || per_cu < 1) { fprintf(stderr, "kernel_launch: occupancy query says %d blocks per CU\n", per_cu); per_cu = 1; }
        (void)hipGetLastError();
        grid = cus * per_cu;
    }
    if (grid < 0) return;
    if (hipMemsetAsync((char*)d_ws + WS_CTL, 0, CTL_BYTES, stream) != hipSuccess) { fprintf(stderr, "kernel_launch: memset failed\n"); return; }
    Params p{};
    const float** pp = (const float**)&p;
    for (int i = 0; i < 22; ++i) pp[i] = (const float*)d_in[i];
    p.out = (float*)d_out; p.ws = (unsigned char*)d_ws;
    void* args[] = {&p};
    hipError_t e = hipLaunchCooperativeKernel((const void*)fwd_megakernel, dim3(grid), dim3(512), args, LDS_BYTES, stream);
    if (e != hipSuccess) fprintf(stderr, "kernel_launch: cooperative launch failed: %s (grid %d)\n", hipGetErrorString(e), grid);
}
```

```cpp
#include <hip/hip_runtime.h>
#include <hip/hip_cooperative_groups.h>
#include <cstdio>
#include <cstdint>
namespace cg = cooperative_groups;
namespace pg8 {
#define PG8_LAS __attribute__((address_space(3)))
typedef unsigned short bf16_t;
typedef short bf16x8 __attribute__((ext_vector_type(8)));
typedef float f32x4 __attribute__((ext_vector_type(4)));
typedef unsigned u32x4 __attribute__((ext_vector_type(4)));
constexpr int BM = 256, BK = 64, HALF = 128, HTB = HALF * BK * 2  , STAGE_BYTES = 8 * HTB, NXCD = 8, WGM = 8;

__host__ __device__ __forceinline__ int lds_byte(int r, int c) { const int st = (r >> 4) * 2 + (c >> 5), rr = r & 15, cc = c & 31, ob = rr * 64 + cc * 2; return st * 1024 + (ob ^ (((ob >> 9) & 1) << 5)); }
__host__ __device__ __forceinline__ void stage_rc(int b, int& R, int& C) { const int st = b / 1024, sb = b % 1024, swz = sb ^ (((sb >> 9) & 1) << 5); R = (st >> 1) * 16 + swz / 64; C = (st & 1) * 32 + (swz % 64) / 2; }
__host__ __device__ __forceinline__ int perm32(int rho) { const int n = rho >> 4, i = rho & 15; return 8 * (i >> 2) + 4 * n + (i & 3); }

struct Unit { int pm, pn; };
struct Gemm { const bf16_t* A; const bf16_t* Bt; int M, N, K; };

struct StaticOrder {
    int nM, nN, nwg, G, c;
    __host__ __device__ void init(int M, int N, int G_, int c_) { nM = M / BM; nN = N / BM; nwg = nM * nN; G = G_; c = c_; }
    __host__ __device__ bool next(int i, Unit& u) const {
        const long L = (long)i * G + c; if (L >= nwg) return false;
        int wgid = (int)L; { const int q = nwg / NXCD, r = nwg % NXCD, xcd = wgid % NXCD, off = wgid / NXCD; wgid = (xcd < r ? xcd * (q + 1) : r * (q + 1) + (xcd - r) * q) + off; }
        const int nig = WGM * nN, gid = wgid / nig, fm = gid * WGM, gsz = (nM - fm) < WGM ? (nM - fm) : WGM;
        u.pm = fm + ((wgid % nig) % gsz); u.pn = (wgid % nig) / gsz; return true;
    }
    __device__ __forceinline__ void a_ready(const Unit&) const {}
    __device__ __forceinline__ void done(const Unit&) const {}
};
__device__ __forceinline__ unsigned cvt_pk_bf16(float lo, float hi) { unsigned r; asm volatile("v_cvt_pk_bf16_f32 %0, %1, %2" : "=v"(r) : "v"(lo), "v"(hi)); return r; }
typedef float f32x2 __attribute__((ext_vector_type(2)));
__device__ __forceinline__ int pg8_tid(PG8_LAS unsigned char* lds) {
    const int slot = (int)__builtin_amdgcn_s_getreg((5 << 11) | 4) & 63;
    const int w = ((volatile PG8_LAS int*)(lds + 131072 + 256))[slot];
    return __builtin_amdgcn_readfirstlane(w) * 64 + (int)__builtin_amdgcn_mbcnt_hi(~0u, __builtin_amdgcn_mbcnt_lo(~0u, 0u));
}
template <class Epi, class Sched, bool ALIGN_EPI = false, bool SP2 = false>
__device__ __forceinline__ void gemm_phase(PG8_LAS unsigned char* lds, const Gemm g, const Sched& S, const Epi& E) {
    int tid_l = pg8_tid(lds); asm volatile("" : "+v"(tid_l));
    const int tid = tid_l, wid = __builtin_amdgcn_readfirstlane(tid >> 6), lane = tid & 63, wr = wid >> 2, wc = wid & 3, fr = lane & 15, fq = lane >> 4;
    const int K = g.K, nt = K / BK;
    unsigned voffA[2], voffB[2];
#pragma unroll
    for (int i = 0; i < 2; ++i) { int R, C; stage_rc(tid * 16 + i * 8192, R, C); const int Rb = Epi::PERM ? ((R & ~31) + perm32(R & 31)) : R;
        voffA[i] = (unsigned)(R * K + C) * 2u; voffB[i] = (unsigned)(Rb * K + C) * 2u; }
    const size_t kstep = (size_t)(BK * 2);
    const size_t hstep = (size_t)HALF * K * 2;
    const size_t tstep = 2 * hstep;
    const unsigned ldsw = (unsigned)wid * 1024u;
    const int aoff = lds_byte(wr * 64 + fr, fq * 8), boff = lds_byte(wc * 32 + fr, fq * 8);
#define PG8_SA(b, h) (((b) * 2 + (h)) * HTB)
#define PG8_SB(b, h) ((4 + (b) * 2 + (h)) * HTB)
#define PG8_STAGE(bufoff, gbase, voff) do { _Pragma("unroll") for (int _i = 0; _i < 2; ++_i) \
        __builtin_amdgcn_global_load_lds((const unsigned*)((const char*)(gbase) + (voff)[_i]), (PG8_LAS unsigned*)(lds + (bufoff) + ldsw + _i * 8192), 16, 0, 0); } while (0)
#define PG8_LDA(dst, b, h) do { _Pragma("unroll") for (int m = 0; m < 4; ++m) _Pragma("unroll") for (int k = 0; k < 2; ++k) dst[m][k] = *(const PG8_LAS bf16x8*)(lds + PG8_SA(b, h) + aoff + m * 2048 + k * 1024); } while (0)
#define PG8_LDB(dst, b, h) do { _Pragma("unroll") for (int n = 0; n < 2; ++n) _Pragma("unroll") for (int k = 0; k < 2; ++k) dst[n][k] = *(const PG8_LAS bf16x8*)(lds + PG8_SB(b, h) + boff + n * 2048 + k * 1024); } while (0)
#define PG8_MMA(ai, bj, At, Bt) do { __builtin_amdgcn_s_setprio(1); _Pragma("unroll") for (int m = 0; m < 4; ++m) _Pragma("unroll") for (int n = 0; n < 2; ++n) _Pragma("unroll") for (int k = 0; k < 2; ++k) \
        acc[ai][bj][m][n] = __builtin_amdgcn_mfma_f32_16x16x32_bf16(Bt[n][k], At[m][k], acc[ai][bj][m][n], 0, 0, 0); __builtin_amdgcn_s_setprio(0); } while (0)
#define PG8_WAIT_V(n) asm volatile("s_waitcnt vmcnt(" #n ")" ::: "memory")
#define PG8_WAIT_L(n) asm volatile("s_waitcnt lgkmcnt(" #n ")" ::: "memory")
#define PG8_BAR __builtin_amdgcn_s_barrier()
#define PG8_SCHED __builtin_amdgcn_sched_barrier(0)
    Unit cur, nxt; int ui = 0;
    if (!S.next(0, cur)) return;
    f32x4 acc[2][2][4][2];
#pragma unroll
    for (int a = 0; a < 2; ++a)
#pragma unroll
        for (int b = 0; b < 2; ++b)
#pragma unroll
            for (int m = 0; m < 4; ++m)
#pragma unroll
                for (int n = 0; n < 2; ++n) acc[a][b][m][n] = (f32x4){0.f, 0.f, 0.f, 0.f};
    bf16x8 At[4][2], B0[2][2], B1[2][2];
    const char* cA = (const char*)g.A + (size_t)cur.pm * tstep; const char* cB = (const char*)g.Bt + (size_t)cur.pn * tstep;
    S.a_ready(cur);
    if constexpr (SP2) {
        PG8_STAGE(PG8_SB(0, 0), cB, voffB); PG8_STAGE(PG8_SB(0, 1), cB + hstep, voffB); PG8_STAGE(PG8_SA(0, 0), cA, voffA); PG8_STAGE(PG8_SA(0, 1), cA + hstep, voffA);
        if (wr == 1) PG8_BAR;
        PG8_WAIT_V(2); PG8_BAR;
        PG8_STAGE(PG8_SB(1, 0), cB + kstep, voffB); PG8_STAGE(PG8_SA(1, 0), cA + kstep, voffA); PG8_STAGE(PG8_SB(1, 1), cB + hstep + kstep, voffB);
        PG8_WAIT_V(6); PG8_BAR;
    } else {
        PG8_STAGE(PG8_SB(0, 0), cB, voffB); PG8_STAGE(PG8_SA(0, 0), cA, voffA); PG8_STAGE(PG8_SB(0, 1), cB + hstep, voffB); PG8_STAGE(PG8_SA(0, 1), cA + hstep, voffA);
        if (wr == 1) PG8_BAR;
        PG8_WAIT_V(4); PG8_BAR;
        PG8_STAGE(PG8_SB(1, 0), cB + kstep, voffB); PG8_STAGE(PG8_SA(1, 0), cA + kstep, voffA); PG8_STAGE(PG8_SB(1, 1), cB + hstep + kstep, voffB);
        PG8_WAIT_V(6); PG8_BAR;
    }
    for (;;) {
        const bool has_next = S.next(ui + 1, nxt);
        const char* nA = has_next ? (const char*)g.A + (size_t)nxt.pm * tstep : cA; const char* nB = has_next ? (const char*)g.Bt + (size_t)nxt.pn * tstep : cB;
        for (int t = 0; t < nt; t += 2) {
            const bool last = (t == nt - 2);
            const char* a1 = cA + (size_t)(t + 1) * kstep;
            const char* a2 = last ? nA : cA + (size_t)(t + 2) * kstep; const char* b2 = last ? nB : cB + (size_t)(t + 2) * kstep;
            const char* a3 = a2 + kstep; const char* b3 = b2 + kstep;
            if (last && has_next) S.a_ready(nxt);
            if constexpr (SP2) {
            PG8_LDB(B0, 0, 0); PG8_LDB(B1, 0, 1); PG8_SCHED; PG8_LDA(At, 0, 0); PG8_STAGE(PG8_SA(1, 1), a1 + hstep, voffA);
            PG8_WAIT_V(8); PG8_WAIT_L(0); PG8_BAR; PG8_MMA(0, 0, At, B0); PG8_MMA(0, 1, At, B1); PG8_BAR; PG8_SCHED;
            PG8_LDA(At, 0, 1); PG8_STAGE(PG8_SB(0, 0), b2, voffB); PG8_STAGE(PG8_SB(0, 1), b2 + hstep, voffB); PG8_STAGE(PG8_SA(0, 0), a2, voffA);
            PG8_WAIT_V(8); PG8_WAIT_L(0); PG8_BAR; PG8_MMA(1, 0, At, B0); PG8_MMA(1, 1, At, B1); PG8_BAR; PG8_SCHED;
            PG8_LDB(B0, 1, 0); PG8_LDB(B1, 1, 1); PG8_SCHED; PG8_LDA(At, 1, 0); PG8_STAGE(PG8_SA(0, 1), a2 + hstep, voffA);
            PG8_WAIT_V(8); PG8_WAIT_L(0); PG8_BAR; PG8_MMA(0, 0, At, B0); PG8_MMA(0, 1, At, B1); PG8_BAR; PG8_SCHED;
            PG8_LDA(At, 1, 1); PG8_STAGE(PG8_SB(1, 0), b3, voffB); PG8_STAGE(PG8_SB(1, 1), b3 + hstep, voffB); PG8_STAGE(PG8_SA(1, 0), a3, voffA);
            PG8_WAIT_V(8); PG8_WAIT_L(0); PG8_BAR; PG8_MMA(1, 0, At, B0); PG8_MMA(1, 1, At, B1); PG8_BAR; PG8_SCHED;
            } else {
            PG8_LDB(B0, 0, 0); PG8_SCHED; PG8_LDA(At, 0, 0); PG8_STAGE(PG8_SA(1, 1), a1 + hstep, voffA);
            PG8_WAIT_L(8); PG8_BAR; PG8_WAIT_L(0); PG8_MMA(0, 0, At, B0); PG8_BAR; PG8_SCHED;
            PG8_LDB(B1, 0, 1); PG8_STAGE(PG8_SB(0, 0), b2, voffB);
            PG8_BAR; PG8_WAIT_L(0); PG8_MMA(0, 1, At, B1); PG8_BAR;
            PG8_LDA(At, 0, 1); PG8_STAGE(PG8_SA(0, 0), a2, voffA);
            PG8_BAR; PG8_WAIT_L(0); PG8_MMA(1, 0, At, B0); PG8_BAR; PG8_SCHED;
            PG8_STAGE(PG8_SB(0, 1), b2 + hstep, voffB);
            PG8_WAIT_V(6); PG8_BAR; PG8_MMA(1, 1, At, B1); PG8_BAR;
            PG8_LDB(B0, 1, 0); PG8_SCHED; PG8_LDA(At, 1, 0); PG8_STAGE(PG8_SA(0, 1), a2 + hstep, voffA);
            PG8_WAIT_L(8); PG8_BAR; PG8_WAIT_L(0); PG8_MMA(0, 0, At, B0); PG8_BAR; PG8_SCHED;
            PG8_LDB(B1, 1, 1); PG8_STAGE(PG8_SB(1, 0), b3, voffB);
            PG8_BAR; PG8_WAIT_L(0); PG8_MMA(0, 1, At, B1); PG8_BAR;
            PG8_LDA(At, 1, 1); PG8_STAGE(PG8_SA(1, 0), a3, voffA);
            PG8_BAR; PG8_WAIT_L(0); PG8_MMA(1, 0, At, B0); PG8_BAR; PG8_SCHED;
            PG8_STAGE(PG8_SB(1, 1), b3 + hstep, voffB);
            PG8_WAIT_V(6); PG8_BAR; PG8_MMA(1, 1, At, B1); PG8_BAR;
            }
        }
        if constexpr (ALIGN_EPI) { if (wr == 0) PG8_BAR; }
        if constexpr (!Epi::AFTER_DRAIN) { E(acc, cur, wr, wc, fr, fq); S.done(cur); }
        if (!has_next) break;
#pragma unroll
        for (int a = 0; a < 2; ++a)
#pragma unroll
            for (int b = 0; b < 2; ++b)
#pragma unroll
                for (int m = 0; m < 4; ++m)
#pragma unroll
                    for (int n = 0; n < 2; ++n) acc[a][b][m][n] = (f32x4){0.f, 0.f, 0.f, 0.f};
        cur = nxt; cA = nA; cB = nB; ++ui;
        if constexpr (ALIGN_EPI) { if (wr == 1) PG8_BAR; }
    }
    PG8_WAIT_V(0);
    if constexpr (!ALIGN_EPI) { if (wr == 0) PG8_BAR; }
    PG8_BAR;
    if constexpr (Epi::AFTER_DRAIN) { E.fused(acc, cur, wr, wc, fr, fq, lds, wid, lane); S.done(cur); }
#undef PG8_SA
#undef PG8_SB
#undef PG8_STAGE
#undef PG8_LDA
#undef PG8_LDB
#undef PG8_MMA
#undef PG8_WAIT_V
#undef PG8_WAIT_L
#undef PG8_BAR
#undef PG8_SCHED
}
}

#ifndef EXP_MIXMASK
#define EXP_MIXMASK 15
#endif
#ifndef EXP_DUPMASK
#define EXP_DUPMASK 15
#endif
#ifndef EXP_DUP
#define EXP_DUP 0
#endif
#ifndef EXP_STOP
#define EXP_STOP 10
#endif
#define LAS __attribute__((address_space(3)))
typedef unsigned short bf16_t;
typedef float f32x4 __attribute__((ext_vector_type(4)));
typedef float f32x2 __attribute__((ext_vector_type(2)));
typedef unsigned u32x4 __attribute__((ext_vector_type(4)));
typedef unsigned u32x2 __attribute__((ext_vector_type(2)));
typedef short bf16x8 __attribute__((ext_vector_type(8)));

constexpr int DM = 1024, NBP = 16, SEQ = 4096, MP = NBP * SEQ, NBS = 8, DSQ = 32, MS = NBS * DSQ, MT = MP + MS;
constexpr int DIN = 2048, DP = 1536, PC_Z = 256, PC_ZS = 512, PC_B = 768, PC_U = 1024, PC_V = 1280, DFF = 2816, NGU = 2 * DFF, WG = 256, PAST = 1024;
constexpr float EPS = 1e-6f;
constexpr size_t MiB = 1u << 20;
constexpr size_t WS_WIN = 0, WS_WOUT = 8 * MiB, WS_WGU = 12 * MiB, WS_WDN = 34 * MiB, WS_WPT = 45 * MiB, WS_WST = 45 * MiB + 65536;
constexpr size_t WS_SSQA = 46 * MiB, WS_SSQB = 51 * MiB, WS_SMALL = 56 * MiB, WS_CTL = 60 * MiB, CTL_BYTES = 16384, WS_HIDS = 61 * MiB;
constexpr int SP_WDW = 0, SP_BDW = SP_WDW + 2 * 31 * 256, SP_LNG = SP_BDW + 512, SP_LNB = SP_LNG + 512, SP_WSC = SP_LNB + 512, SP_BS = SP_WSC + 2 * 3 * 256, SP_GF = SP_BS + 2 * 4 * 128,
              SP_STP = SP_GF + 1024, SP_STC = SP_STP + 2 * 8 * 15 * 256, SP_STS = SP_STC + 2 * 8 * 30 * 256, SP_END = SP_STS + 2 * 8 * 2 * 256;
static_assert(WS_SMALL + (size_t)SP_END * 4 <= WS_CTL && WS_HIDS + (size_t)MS * DFF * 2 <= 64 * MiB, "ws map small");
constexpr size_t WS_XB = 64 * MiB, WS_X = 193 * MiB, WS_P = 450 * MiB, WS_MIX = 707 * MiB, WS_HID = 450 * MiB, WS_PART = 836 * MiB, WS_WDNS = 840 * MiB, WS_END = 852 * MiB;
constexpr int KH = DFF / 2;
static_assert(WS_PART + 2ull * MS * DM * 4 <= WS_WDNS && WS_WDNS + 2ull * 2 * DM * KH * 2 <= WS_END && KH % 128 == 0 && KH % 64 == 0, "split-K buffers");
static_assert(WS_XB + (size_t)MT * DM * 2 <= WS_X && WS_X + (size_t)MT * DM * 4 <= WS_P && WS_P + (size_t)MT * DIN * 2 <= WS_MIX && WS_MIX + (size_t)MT * DM * 2 <= WS_PART && WS_HID + (size_t)MT * DFF * 2 <= WS_PART, "ws map");
static_assert(WS_SSQA + (size_t)MT * 64 <= WS_SSQB && WS_SSQB + (size_t)MT * 64 <= WS_XB, "ws map ssq");
constexpr size_t O_Y = 0, O_POOLP = (size_t)MT * DM, O_POOLS = O_POOLP + 2 * 16 * 15 * 256, O_CONVP = O_POOLS + 2 * 8 * 15 * 256, O_CONVS = O_CONVP + 2 * 16 * 30 * 256,
                 O_SCP = O_CONVS + 2 * 8 * 30 * 256, O_SCS = O_SCP + 2 * 16 * 2 * 256, O_VS = O_SCS + 2 * 8 * 2 * 256, O_END = O_VS + 2 * 8 * 32 * 256;
constexpr int LDS_BYTES = 136192;
constexpr int LDS_RC = 131072 + 512;

__device__ __forceinline__ float bf_lo(unsigned u) { return __uint_as_float(u << 16); }
__device__ __forceinline__ float bf_hi(unsigned u) { return __uint_as_float(u & 0xffff0000u); }
typedef __bf16 bf16x2_t __attribute__((ext_vector_type(2)));
__device__ __forceinline__ unsigned pk_bf16(float lo, float hi) { const f32x2 v = {lo, hi}; const bf16x2_t b = __builtin_convertvector(v, bf16x2_t); return __builtin_bit_cast(unsigned, b); }
__device__ __forceinline__ float wave_sum(float v) {
#pragma unroll
    for (int o = 1; o < 64; o <<= 1) v += __shfl_xor(v, o);
    return v;
}
__device__ __forceinline__ float sigmoidf_(float x) { return 1.0f / (1.0f + __expf(-x)); }

__device__ __forceinline__ float row_rstd(const float* ssq, int row, int fq) {
    const f32x4 s = *(const f32x4*)(ssq + (size_t)row * 16 + 4 * fq);
    float t = (s[0] + s[1]) + (s[2] + s[3]);
    t += __shfl_xor(t, 16); t += __shfl_xor(t, 32);
    return rsqrtf(t * (1.0f / DM) + EPS);
}
__device__ __forceinline__ bool rc_hit(LAS float* rc, const int want, const int wave) { return __builtin_amdgcn_readfirstlane(*(volatile LAS int*)((LAS int*)(rc + 1024) + wave)) == want; }
__device__ __forceinline__ float rc_get(LAS float* rc, const bool hit, const float* ssq, const int row, const int wave, const int slot, const int fr, const int fq) {
    LAS float* e = rc + wave * 128 + slot * 16 + fr;
    if (hit) return *e;
    const float r = row_rstd(ssq, row, fq); if (fq == 0) *e = r; return r;
}
__device__ __forceinline__ void rc_commit(LAS float* rc, const bool hit, const int want, const int wave) { if (!hit) *(volatile LAS int*)((LAS int*)(rc + 1024) + wave) = want; }
struct EpiInProj {
    static constexpr bool PERM = true, AFTER_DRAIN = false;
    bf16_t* P; const float* ssq; LAS float* rc; int salt;
    __device__ __forceinline__ void operator()(const f32x4 (&acc)[2][2][4][2], const pg8::Unit& u, int wr, int wc, int fr, int fq) const {
        asm volatile("" : "+v"(fr));
        const int row0 = u.pm * 256 + wr * 64 + fr, pn = u.pn;
        const int rcw = wr * 4 + wc, rcwant = salt * 1024 + u.pm + 1; const bool rchit = rc_hit(rc, rcwant, rcw);
        const int mode = (pn == 1 || pn == 2) ? 1 : ((pn == 3 || pn == 4) ? 2 : 0);
        const int dcol = (pn == 0) ? 0 : (mode == 1 ? PC_Z + 128 * (pn - 1) : (mode == 2 ? PC_ZS + 128 * (pn - 3) : PC_B + 256 * (pn - 5)));
        const int col0 = dcol + wc * 32 + 8 * fq;
#pragma unroll
        for (int ai = 0; ai < 2; ++ai)
#pragma unroll
            for (int m = 0; m < 4; ++m) {
                const int row = row0 + ai * 128 + m * 16; const float rs = rc_get(rc, rchit, ssq, row, rcw, ai * 4 + m, fr, fq);
                bf16_t* rowp = P + (size_t)row * DP + col0;
                if (mode == 0) {
#pragma unroll
                    for (int bj = 0; bj < 2; ++bj) { const f32x4 v0 = acc[ai][bj][m][0] * rs, v1 = acc[ai][bj][m][1] * rs;
                        u32x4 w; w.x = pk_bf16(v0[0], v0[1]); w.y = pk_bf16(v0[2], v0[3]); w.z = pk_bf16(v1[0], v1[1]); w.w = pk_bf16(v1[2], v1[3]);
                        __builtin_nontemporal_store(w, (u32x4*)(rowp + bj * 128)); }
                } else {
                    float h[8];
                    const float c1 = rs * -1.4426950408889634f, rs2 = rs * rs;
#pragma unroll
                    for (int n = 0; n < 2; ++n)
#pragma unroll
                        for (int j = 0; j < 4; j += 2) { const f32x2 a = {acc[ai][0][m][n][j], acc[ai][0][m][n][j + 1]}, b = {acc[ai][1][m][n][j], acc[ai][1][m][n][j + 1]};
                            f32x2 hh;
                            if (mode == 1) { const f32x2 t = b * c1; f32x2 e; e.x = __builtin_amdgcn_exp2f(t.x); e.y = __builtin_amdgcn_exp2f(t.y);
                                const f32x2 d = e + 1.0f; f32x2 r; r.x = __builtin_amdgcn_rcpf(d.x); r.y = __builtin_amdgcn_rcpf(d.y); hh = (a * rs) * r; }
                            else hh = (a * b) * rs2;
                            h[n * 4 + j] = hh.x; h[n * 4 + j + 1] = hh.y; }
                    u32x4 w; w.x = pk_bf16(h[0], h[1]); w.y = pk_bf16(h[2], h[3]); w.z = pk_bf16(h[4], h[5]); w.w = pk_bf16(h[6], h[7]);
                    __builtin_nontemporal_store(w, (u32x4*)rowp);
                }
            }
        rc_commit(rc, rchit, rcwant, rcw);
    }
};
struct EpiSwiGLU {
    static constexpr bool PERM = true, AFTER_DRAIN = false;
    bf16_t* H; const float* ssq; LAS float* rc; int salt;
    __device__ __forceinline__ void operator()(const f32x4 (&acc)[2][2][4][2], const pg8::Unit& u, int wr, int wc, int fr, int fq) const {
        asm volatile("" : "+v"(fr));
        const int row0 = u.pm * 256 + wr * 64 + fr, col0 = u.pn * 128 + wc * 32 + 8 * fq;
        const int rcw = wr * 4 + wc, rcwant = salt * 1024 + u.pm + 1; const bool rchit = rc_hit(rc, rcwant, rcw);
#pragma unroll
        for (int ai = 0; ai < 2; ++ai)
#pragma unroll
            for (int m = 0; m < 4; ++m) {
                const int row = row0 + ai * 128 + m * 16; const float rs = rc_get(rc, rchit, ssq, row, rcw, ai * 4 + m, fr, fq);
                float h[8];
                const float c1 = rs * -1.4426950408889634f, rs2 = rs * rs;
#pragma unroll
                for (int n = 0; n < 2; ++n)
#pragma unroll
                    for (int j = 0; j < 4; j += 2) { const f32x2 ag = {acc[ai][0][m][n][j], acc[ai][0][m][n][j + 1]}, au = {acc[ai][1][m][n][j], acc[ai][1][m][n][j + 1]};
                        const f32x2 t = ag * c1; f32x2 e; e.x = __builtin_amdgcn_exp2f(t.x); e.y = __builtin_amdgcn_exp2f(t.y);
                        const f32x2 d = e + 1.0f; f32x2 r; r.x = __builtin_amdgcn_rcpf(d.x); r.y = __builtin_amdgcn_rcpf(d.y);
                        const f32x2 hh = (ag * au) * (r * rs2); h[n * 4 + j] = hh.x; h[n * 4 + j + 1] = hh.y; }
                u32x4 w; w.x = pk_bf16(h[0], h[1]); w.y = pk_bf16(h[2], h[3]); w.z = pk_bf16(h[4], h[5]); w.w = pk_bf16(h[6], h[7]);
                __builtin_nontemporal_store(w, (u32x4*)(H + (size_t)row * DFF + col0));
            }
        rc_commit(rc, rchit, rcwant, rcw);
    }
};
struct EpiResid {
    static constexpr bool PERM = false, AFTER_DRAIN = false;
    const float* rp; bf16_t* XB; float* ssq;
    __device__ __forceinline__ void operator()(const f32x4 (&acc)[2][2][4][2], const pg8::Unit& u, int wr, int wc, int fr, int fq) const {
        asm volatile("" : "+v"(fr));
        const int row0 = u.pm * 256 + wr * 64 + fr, col0 = u.pn * 256 + wc * 32 + 4 * fq;
        const bool rf32 = (rp != nullptr) && (u.pm < MP / 256);
#pragma unroll
        for (int ai = 0; ai < 2; ++ai)
#pragma unroll
            for (int m = 0; m < 4; ++m) {
                const int row = row0 + ai * 128 + m * 16; const size_t off = (size_t)row * DM + col0; float q = 0.f;
                f32x4 r4[2][2];
                if (rf32) {
#pragma unroll
                    for (int bj = 0; bj < 2; ++bj)
#pragma unroll
                        for (int n = 0; n < 2; ++n) r4[bj][n] = *(const f32x4*)(rp + off + bj * 128 + n * 16);
                } else {
#pragma unroll
                    for (int bj = 0; bj < 2; ++bj)
#pragma unroll
                        for (int n = 0; n < 2; ++n) { const u32x2 w = *(const u32x2*)(XB + off + bj * 128 + n * 16); r4[bj][n] = (f32x4){bf_lo(w.x), bf_hi(w.x), bf_lo(w.y), bf_hi(w.y)}; }
                }
#pragma unroll
                for (int bj = 0; bj < 2; ++bj)
#pragma unroll
                    for (int n = 0; n < 2; ++n) { const f32x4 x4 = r4[bj][n] + acc[ai][bj][m][n];
                        q += (x4[0] * x4[0] + x4[1] * x4[1]) + (x4[2] * x4[2] + x4[3] * x4[3]);
                        u32x2 w; w.x = pk_bf16(x4[0], x4[1]); w.y = pk_bf16(x4[2], x4[3]); *(u32x2*)(XB + off + bj * 128 + n * 16) = w; }
                q += __shfl_xor(q, 16); q += __shfl_xor(q, 32);
                if (fq == 0) ssq[(size_t)row * 16 + u.pn * 4 + wc] = q;
                if (m & 1) asm volatile("" ::: "memory");
            }
    }
};

struct Params {
    const float* x_prompt; const float* x_sample; const float* st_pool; const float* st_conv; const float* st_sc; const float* g_mix; const float* w_in; const float* w_pool;
    const float* pool_scale; const float* w_dw; const float* b_dw; const float* ln_g; const float* ln_b; const float* w_sconv; const float* w_s; const float* b_s; const float* w_out;
    const float* g_ffn; const float* w_gate; const float* w_up; const float* w_down; const float* g_final;
    float* out; unsigned char* ws;
};

__device__ __forceinline__ void transpose_item(const float* W, const float* gk, int K, int N, bf16_t* WT, int dst_row0, LAS float* scr, int k0, int n0, int lane, bf16_t* WT2 = nullptr, int K2 = 0, int k02 = 0) {
    float tv[32];
#pragma unroll
    for (int i = 0; i < 32; ++i) { const int kk = 2 * i + (lane >> 5); tv[i] = W[(size_t)(k0 + kk) * N + n0 + (lane & 31)]; }
#pragma unroll
    for (int i = 0; i < 32; ++i) { const int kk = 2 * i + (lane >> 5); float v = tv[i]; if (gk) v *= gk[k0 + kk]; scr[kk * 33 + (lane & 31)] = v; }
    asm volatile("s_waitcnt lgkmcnt(0)" ::: "memory");
    const int c = lane & 7;
#pragma unroll
    for (int j = 0; j < 4; ++j) { const int n = (lane >> 3) + 8 * j; const LAS float* s = scr + (8 * c) * 33 + n;
        u32x4 o; o.x = pk_bf16(s[0 * 33], s[1 * 33]); o.y = pk_bf16(s[2 * 33], s[3 * 33]); o.z = pk_bf16(s[4 * 33], s[5 * 33]); o.w = pk_bf16(s[6 * 33], s[7 * 33]);
        *(u32x4*)(WT + (size_t)(dst_row0 + n) * K + k0 + 8 * c) = o;
        if (WT2) *(u32x4*)(WT2 + (size_t)(dst_row0 + n) * K2 + k02 + 8 * c) = o; }
    asm volatile("s_waitcnt lgkmcnt(0)" ::: "memory");
}
__device__ __forceinline__ void prologue(const Params& p, LAS unsigned char* lds, int tid, int lane, int wave) {
    LAS float* scr = (LAS float*)(lds + wave * 16384);
    const int gw = blockIdx.x * 8 + wave, NGW = gridDim.x * 8;
    constexpr int I_IN = (DM / 64) * (DIN / 32), I_OUT = (DM / 64) * (DM / 32), I_G = (DM / 64) * (DFF / 32), I_DN = (DFF / 64) * (DM / 32);
    constexpr int I_LAYER = I_IN + I_OUT + 2 * I_G + I_DN;
    bf16_t* WIN = (bf16_t*)(p.ws + WS_WIN); bf16_t* WOUT = (bf16_t*)(p.ws + WS_WOUT); bf16_t* WGU = (bf16_t*)(p.ws + WS_WGU); bf16_t* WDN = (bf16_t*)(p.ws + WS_WDN);
    for (int it = gw; it < 2 * I_LAYER; it += NGW) {
        const int l = it / I_LAYER; int r = it % I_LAYER;
        if (r < I_IN) { const int nb = DIN / 32, k0 = 64 * (r / nb), n0 = 32 * (r % nb); const int seg = n0 >> 8, off = n0 & 255, hi = off >> 7, lo = off & 127;
            const int drow = (seg == 0) ? off : (seg == 1) ? 256 * (1 + hi) + lo : (seg == 2) ? 256 * (1 + hi) + 128 + lo : (seg == 3) ? 256 * (3 + hi) + lo : (seg == 5) ? 256 * (3 + hi) + 128 + lo : (seg == 4) ? 256 * 5 + off : 256 * seg + off;
            transpose_item(p.w_in + (size_t)l * DM * DIN, p.g_mix + l * DM, DM, DIN, WIN + (size_t)l * DIN * DM, drow, scr, k0, n0, lane); continue; } r -= I_IN;
        if (r < I_OUT) { const int nb = DM / 32, k0 = 64 * (r / nb), n0 = 32 * (r % nb); transpose_item(p.w_out + (size_t)l * DM * DM, nullptr, DM, DM, WOUT + (size_t)l * DM * DM, n0, scr, k0, n0, lane); continue; } r -= I_OUT;
        if (r < I_G) { const int nb = DFF / 32, k0 = 64 * (r / nb), n0 = 32 * (r % nb); transpose_item(p.w_gate + (size_t)l * DM * DFF, p.g_ffn + l * DM, DM, DFF, WGU + (size_t)l * NGU * DM, (n0 >> 7) * 256 + (n0 & 127), scr, k0, n0, lane); continue; } r -= I_G;
        if (r < I_G) { const int nb = DFF / 32, k0 = 64 * (r / nb), n0 = 32 * (r % nb); transpose_item(p.w_up + (size_t)l * DM * DFF, p.g_ffn + l * DM, DM, DFF, WGU + (size_t)l * NGU * DM, (n0 >> 7) * 256 + 128 + (n0 & 127), scr, k0, n0, lane); continue; } r -= I_G;
        { const int nb = DM / 32, k0 = 64 * (r / nb), n0 = 32 * (r % nb); const int kh = k0 / KH; transpose_item(p.w_down + (size_t)l * DFF * DM, nullptr, DFF, DM, WDN + (size_t)l * DM * DFF, n0, scr, k0, n0, lane, (bf16_t*)(p.ws + WS_WDNS) + (size_t)(l * 2 + kh) * DM * KH, KH, k0 - kh * KH); }
    }
    {
        bf16_t* WPT = (bf16_t*)(p.ws + WS_WPT); bf16_t* WST = (bf16_t*)(p.ws + WS_WST);
        const int gt = blockIdx.x * 512 + tid, NGT = gridDim.x * 512;
        for (int e = gt; e < 2 * 4 * 64 * 64; e += NGT) { const int c = e & 63, d = (e >> 6) & 63, lg = e >> 12;
            const float v = p.w_pool[((size_t)lg * 64 + c) * 64 + d] * p.pool_scale[(lg >> 2) * 256 + (lg & 3) * 64 + d]; WPT[e] = (bf16_t)(pk_bf16(v, 0.f) & 0xffffu); }
        for (int e = gt; e < 2 * 4 * 128 * 128; e += NGT) { const int j = e & 127, i = (e >> 7) & 127; const float v = (j <= i) ? p.w_s[e] : 0.f; WST[e] = (bf16_t)(pk_bf16(v, 0.f) & 0xffffu); }
    }
    {
        float* SP = (float*)(p.ws + WS_SMALL);
        const int gt = blockIdx.x * 512 + tid, NGT = gridDim.x * 512;
        for (int e = gt; e < SP_END; e += NGT) {
            float v;
            if (e < SP_BDW) v = p.w_dw[e - SP_WDW]; else if (e < SP_LNG) v = p.b_dw[e - SP_BDW]; else if (e < SP_LNB) v = p.ln_g[e - SP_LNG]; else if (e < SP_WSC) v = p.ln_b[e - SP_LNB];
            else if (e < SP_BS) v = p.w_sconv[e - SP_WSC]; else if (e < SP_GF) v = p.b_s[e - SP_BS]; else if (e < SP_STP) v = p.g_final[e - SP_GF]; else if (e < SP_STC) v = p.st_pool[e - SP_STP];
            else if (e < SP_STS) v = p.st_conv[e - SP_STC]; else v = p.st_sc[e - SP_STS];
            SP[e] = v;
        }
    }
}

__device__ __forceinline__ void convert_rows(const Params& p, int lane, const int gw, const int NGW, const int row_lo, const int row_hi) {
    bf16_t* XB = (bf16_t*)(p.ws + WS_XB); float* SSQ = (float*)(p.ws + WS_SSQA);
    for (int m0 = row_lo + gw; m0 < row_hi; m0 += 4 * NGW) {
        f32x4 v[4][4]; float s[4];
#pragma unroll
        for (int h = 0; h < 4; ++h) { const int m = m0 + h * NGW; const int mm = m < row_hi ? m : m0;
            const float* xrow = (mm < MP) ? p.x_prompt + (size_t)mm * DM : p.x_sample + (size_t)(mm - MP) * DM; const f32x4* xr = (const f32x4*)xrow + lane;
#pragma unroll
            for (int j = 0; j < 4; ++j) v[h][j] = xr[64 * j]; }
#pragma unroll
        for (int h = 0; h < 4; ++h) { const int m = m0 + h * NGW;
            float q = 0.f;
#pragma unroll
            for (int j = 0; j < 4; ++j) q += (v[h][j][0] * v[h][j][0] + v[h][j][1] * v[h][j][1]) + (v[h][j][2] * v[h][j][2] + v[h][j][3] * v[h][j][3]);
            s[h] = wave_sum(q);
            if (m < row_hi) { u32x2* o8 = (u32x2*)(XB + (size_t)m * DM) + lane;
#pragma unroll
                for (int j = 0; j < 4; ++j) { u32x2 w; w.x = pk_bf16(v[h][j][0], v[h][j][1]); w.y = pk_bf16(v[h][j][2], v[h][j][3]); o8[64 * j] = w; }
                if (lane < 16) SSQ[(size_t)m * 16 + lane] = (lane == 0) ? s[h] : 0.f; } }
    }
}

struct Tile { int g0, R, t0, sb, b, last; };
__device__ __forceinline__ Tile prompt_tile(int q, int R) { Tile t; t.g0 = q * R; t.R = R; t.t0 = t.g0 & (SEQ - 1); t.sb = -1; t.b = t.g0 / SEQ; t.last = (t.t0 + R == SEQ); return t; }
__device__ __forceinline__ Tile sample_tile(int b) { Tile t; t.g0 = MP + b * DSQ; t.R = DSQ; t.t0 = PAST; t.sb = b; t.b = b; t.last = 1; return t; }
__device__ __forceinline__ void unpack8(const u32x4 w, float* f) { f[0] = bf_lo(w.x); f[1] = bf_hi(w.x); f[2] = bf_lo(w.y); f[3] = bf_hi(w.y); f[4] = bf_lo(w.z); f[5] = bf_hi(w.z); f[6] = bf_lo(w.w); f[7] = bf_hi(w.w); }
__device__ __forceinline__ void store8f(float* dst, const float* f) { *(f32x4*)dst = (f32x4){f[0], f[1], f[2], f[3]}; *(f32x4*)(dst + 4) = (f32x4){f[4], f[5], f[6], f[7]}; }
__device__ __forceinline__ void load8f(const float* src, float* f) { const f32x4 a = *(const f32x4*)src, b = *(const f32x4*)(src + 4); f[0] = a[0]; f[1] = a[1]; f[2] = a[2]; f[3] = a[3]; f[4] = b[0]; f[5] = b[1]; f[6] = b[2]; f[7] = b[3]; }
#define WG_BAR() do { asm volatile("s_waitcnt lgkmcnt(0)" ::: "memory"); __builtin_amdgcn_s_barrier(); asm volatile("" ::: "memory"); } while (0)

template <int H, int K>
__device__ __forceinline__ void xstep(float (&v)[16], int lane) {
    const bool up = (lane >> K) & 1;
#pragma unroll
    for (int i = 0; i < H; ++i) { const float send = up ? v[i] : v[i + H]; const float keep = up ? v[i + H] : v[i]; v[i] = keep + __shfl_xor(send, 1 << K); }
}
__device__ __forceinline__ float xreduce16(float (&v)[16], int lane) {
    xstep<8, 0>(v, lane); xstep<4, 1>(v, lane); xstep<2, 2>(v, lane); xstep<1, 3>(v, lane);
    float r = v[0]; r += __shfl_xor(r, 16); r += __shfl_xor(r, 32); return r;
}
__device__ __forceinline__ void conv_block(const LAS float* z, LAS float* st, const float (&w)[31], float bias, int r0, int c, int lane, int wq, float (&cv)[8]) {
    float win[38];
#pragma unroll
    for (int i = 0; i < 38; ++i) win[i] = z[(r0 + i) * 256 + c];
    float sv[16];
#pragma unroll
    for (int j = 0; j < 8; ++j) { float a = bias;
#pragma unroll
        for (int k = 0; k < 31; ++k) a += w[k] * win[j + k];
        asm volatile("" : "+v"(a));
        cv[j] = a; sv[2 * j] = a; sv[2 * j + 1] = a * a; }
    const float r = xreduce16(sv, lane);
    const int idx = ((lane & 1) << 3) | ((lane & 2) << 1) | ((lane & 4) >> 1) | ((lane & 8) >> 3);
    if (lane < 16) st[((r0 + (idx >> 1)) * 4 + wq) * 2 + (idx & 1)] = r;
}
__device__ __forceinline__ void conv_norm(const LAS float* st, const float (&cv)[8], int r0, float lg, float lb, bf16_t* mixrow) {
#pragma unroll
    for (int j = 0; j < 8; ++j) { const LAS float* sp = st + (r0 + j) * 8;
        const float s = (sp[0] + sp[2]) + (sp[4] + sp[6]), q = (sp[1] + sp[3]) + (sp[5] + sp[7]);
        const float mean = s * (1.0f / 256.0f); float var = q * (1.0f / 256.0f) - mean * mean; var = var < 0.f ? 0.f : var;
        const float n = (cv[j] - mean) * rsqrtf(var + EPS) * lg + lb;
        const float y = n * __builtin_amdgcn_rcpf(1.0f + __builtin_amdgcn_exp2f(n * -1.4426950408889634f));
        mixrow[(size_t)j * DM] = (bf16_t)(pk_bf16(y, 0.f) & 0xffffu); }
}
__device__ __forceinline__ void mix_conv(const Params& p, int l, const Tile t, const bf16_t* P, bf16_t* MIX, LAS unsigned char* lds, int tid) {
    LAS float* z = (LAS float*)lds;
    LAS float* st = (LAS float*)(lds + 94 * 256 * 4);
    const float* SP = (const float*)(p.ws + WS_SMALL);
    const int lane = tid & 63, wave = tid >> 6;
    const int nitems = (t.R + 30) * 32;
    const bool hist_from_p = (t.sb < 0) && (t.t0 != 0);
    float* oconv = p.out + ((t.sb < 0) ? O_CONVP + (size_t)(l * NBP + t.b) * 30 * 256 : O_CONVS + (size_t)(l * NBS + t.b) * 30 * 256);
    {
        u32x4 A[6], G[6];
#pragma unroll
        for (int i = 0; i < 6; ++i) { const int idx = tid + 512 * i, rr = idx >> 5, c8 = (idx & 31) * 8, rrel = rr - 30;
            A[i] = (u32x4){0u, 0u, 0u, 0u}; G[i] = (u32x4){0u, 0u, 0u, 0u};
            if (idx < nitems) {
                if (rrel >= 0 || hist_from_p) A[i] = *(const u32x4*)(P + (size_t)(t.g0 + rrel) * DP + PC_Z + c8);
                else if (t.sb >= 0) { const float* sp = SP + SP_STC + ((size_t)(l * NBS + t.b) * 30 + rr) * 256 + c8; A[i] = *(const u32x4*)sp; G[i] = *(const u32x4*)(sp + 4); } } }
#pragma unroll
        for (int i = 0; i < 6; ++i) { const int idx = tid + 512 * i, rr = idx >> 5, c8 = (idx & 31) * 8, rrel = rr - 30;
            if (idx < nitems) { float zz[8];
                if (rrel >= 0 || hist_from_p) unpack8(A[i], zz);
                else { zz[0] = __uint_as_float(A[i].x); zz[1] = __uint_as_float(A[i].y); zz[2] = __uint_as_float(A[i].z); zz[3] = __uint_as_float(A[i].w);
                       zz[4] = __uint_as_float(G[i].x); zz[5] = __uint_as_float(G[i].y); zz[6] = __uint_as_float(G[i].z); zz[7] = __uint_as_float(G[i].w); }
                *(LAS f32x4*)(z + rr * 256 + c8) = (f32x4){zz[0], zz[1], zz[2], zz[3]}; *(LAS f32x4*)(z + rr * 256 + c8 + 4) = (f32x4){zz[4], zz[5], zz[6], zz[7]};
                if (t.last && rrel >= t.R - 30) store8f(oconv + (size_t)(rrel - (t.R - 30)) * 256 + c8, zz); } }
    }
    const int c = tid & 255, half = tid >> 8, rph = t.R >> 1, nblk = rph >> 3;
    float w[31];
#pragma unroll
    for (int k = 0; k < 31; ++k) w[k] = SP[SP_WDW + (l * 31 + k) * 256 + c];
    const float bias = SP[SP_BDW + l * 256 + c];
    const float lg = SP[SP_LNG + l * 256 + c], lb = SP[SP_LNB + l * 256 + c];
    WG_BAR();
    float cv[4][8];
#pragma unroll
    for (int blk = 0; blk < 4; ++blk) if (blk < nblk) conv_block(z, st, w, bias, half * rph + blk * 8, c, lane, wave & 3, cv[blk]);
    WG_BAR();
#pragma unroll
    for (int blk = 0; blk < 4; ++blk) if (blk < nblk) { const int r0 = half * rph + blk * 8; conv_norm(st, cv[blk], r0, lg, lb, MIX + (size_t)(t.g0 + r0) * DM + 256 + c); }
    WG_BAR();
}

__device__ __forceinline__ void mix_pool(const Params& p, int l, const Tile t, const bf16_t* P, bf16_t* MIX, LAS unsigned char* lds, int tid) {
    LAS float* xs = (LAS float*)lds;
    LAS bf16_t* pre = (LAS bf16_t*)(lds + 79 * 256 * 4);
    const float* SP = (const float*)(p.ws + WS_SMALL);
    const int lane = tid & 63, wave = tid >> 6;
    const int nitems = (t.R + 15) * 32;
    const bool hist_from_p = (t.sb < 0) && (t.t0 != 0);
    float* opool = p.out + ((t.sb < 0) ? O_POOLP + (size_t)(l * NBP + t.b) * 15 * 256 : O_POOLS + (size_t)(l * NBS + t.b) * 15 * 256);
    {
        u32x4 A[5], B[5];
#pragma unroll
        for (int i = 0; i < 5; ++i) { const int idx = tid + 512 * i, rr = idx >> 5, c8 = (idx & 31) * 8, rrel = rr - 15;
            A[i] = (u32x4){0u, 0u, 0u, 0u}; B[i] = (u32x4){0u, 0u, 0u, 0u};
            if (idx < nitems) {
                if (rrel >= 0 || hist_from_p) A[i] = *(const u32x4*)(P + (size_t)(t.g0 + rrel) * DP + c8);
                else if (t.sb >= 0) { const float* sp = SP + SP_STP + ((size_t)(l * NBS + t.b) * 15 + rr) * 256 + c8; A[i] = *(const u32x4*)sp; B[i] = *(const u32x4*)(sp + 4); } } }
#pragma unroll
        for (int i = 0; i < 5; ++i) { const int idx = tid + 512 * i, rr = idx >> 5, c8 = (idx & 31) * 8, rrel = rr - 15;
            if (idx < nitems) { float v[8];
                if (rrel >= 0 || hist_from_p) unpack8(A[i], v);
                else { v[0] = __uint_as_float(A[i].x); v[1] = __uint_as_float(A[i].y); v[2] = __uint_as_float(A[i].z); v[3] = __uint_as_float(A[i].w);
                       v[4] = __uint_as_float(B[i].x); v[5] = __uint_as_float(B[i].y); v[6] = __uint_as_float(B[i].z); v[7] = __uint_as_float(B[i].w); }
                *(LAS f32x4*)(xs + rr * 256 + c8) = (f32x4){v[0], v[1], v[2], v[3]}; *(LAS f32x4*)(xs + rr * 256 + c8 + 4) = (f32x4){v[4], v[5], v[6], v[7]};
                if (t.last && rrel >= t.R - 15) store8f(opool + (size_t)(rrel - (t.R - 15)) * 256 + c8, v); } }
    }
    const int g = wave >> 1, rh = wave & 1, fr = lane & 15, fq = lane >> 4, rph = t.R >> 1, mt = t.R >> 5;
    bf16x8 bf[4][2];
    {
        const bf16_t* WPT = (const bf16_t*)(p.ws + WS_WPT) + (size_t)(l * 4 + g) * 64 * 64;
#pragma unroll
        for (int n = 0; n < 4; ++n)
#pragma unroll
            for (int k = 0; k < 2; ++k) bf[n][k] = *(const bf16x8*)(WPT + (16 * n + fr) * 64 + 32 * k + 8 * fq);
    }
    WG_BAR();
    {
        const int c = tid & 255, half = tid >> 8, gg = c >> 6, w = 2 << gg;
        float mk[16];
#pragma unroll
        for (int j = 0; j < 16; ++j) mk[j] = (j < w) ? 1.0f : 0.0f;
        for (int r0 = half * rph; r0 < (half + 1) * rph; r0 += 4) {
            float v[19];
#pragma unroll
            for (int i = 0; i < 19; ++i) v[i] = xs[(r0 + i) * 256 + c];
#pragma unroll
            for (int q = 0; q < 4; ++q) { float s = 0.f;
#pragma unroll
                for (int j = 0; j < 16; ++j) s += mk[j] * v[q + 15 - j];
                const int pos = t.t0 + r0 + q; const float cnt = (float)((pos + 1 < w) ? pos + 1 : w);
                const float pv = s * __builtin_amdgcn_rcpf(cnt) - v[q + 15];
                pre[(r0 + q) * 264 + c] = (bf16_t)(pk_bf16(pv, 0.f) & 0xffffu); }
        }
    }
    WG_BAR();
#pragma unroll
    for (int m = 0; m < 2; ++m) {
        if (m < mt) {
            const int row = rh * rph + 16 * m + fr;
            bf16x8 af[2];
#pragma unroll
            for (int k = 0; k < 2; ++k) af[k] = *(const LAS bf16x8*)(pre + row * 264 + g * 64 + 32 * k + 8 * fq);
#pragma unroll
            for (int n = 0; n < 4; ++n) { f32x4 a = {0.f, 0.f, 0.f, 0.f};
#pragma unroll
                for (int k = 0; k < 2; ++k) a = __builtin_amdgcn_mfma_f32_16x16x32_bf16(bf[n][k], af[k], a, 0, 0, 0);
                u32x2 o; o.x = pk_bf16(a[0], a[1]); o.y = pk_bf16(a[2], a[3]);
                *(u32x2*)(MIX + (size_t)(t.g0 + row) * DM + g * 64 + 16 * n + 4 * fq) = o; }
        }
    }
    WG_BAR();
}

__device__ __forceinline__ void mix_sconv(const Params& p, int l, const Tile t, const bf16_t* P, bf16_t* MIX, int tid) {
    const bool hist_from_p = (t.sb < 0) && (t.t0 != 0);
    const float* SP = (const float*)(p.ws + WS_SMALL);
    float* osc = p.out + ((t.sb < 0) ? O_SCP + (size_t)(l * NBP + t.b) * 2 * 256 : O_SCS + (size_t)(l * NBS + t.b) * 2 * 256);
    const int c8 = (tid & 31) * 8, r0 = (tid >> 5) * 4;
    if (r0 >= t.R) return;
    u32x4 XS[6], CG[6], BG[4];
#pragma unroll
    for (int i = 0; i < 6; ++i) { const int rrel = r0 - 2 + i; XS[i] = (u32x4){0u, 0u, 0u, 0u}; CG[i] = (u32x4){0u, 0u, 0u, 0u};
        if (rrel >= 0 || hist_from_p) XS[i] = *(const u32x4*)(P + (size_t)(t.g0 + rrel) * DP + PC_ZS + c8);
        else if (t.sb >= 0) { const float* sp = SP + SP_STS + ((size_t)(l * NBS + t.b) * 2 + (rrel + 2)) * 256 + c8; XS[i] = *(const u32x4*)sp; CG[i] = *(const u32x4*)(sp + 4); } }
#pragma unroll
    for (int i = 0; i < 4; ++i) BG[i] = *(const u32x4*)(P + (size_t)(t.g0 + r0 + i) * DP + PC_B + c8);
    float w0[8], w1[8], w2[8];
    load8f(SP + SP_WSC + (l * 3 + 0) * 256 + c8, w0); load8f(SP + SP_WSC + (l * 3 + 1) * 256 + c8, w1); load8f(SP + SP_WSC + (l * 3 + 2) * 256 + c8, w2);
    float z[6][8];
#pragma unroll
    for (int i = 0; i < 6; ++i) { const int rrel = r0 - 2 + i;
        if (rrel >= 0 || hist_from_p) unpack8(XS[i], z[i]);
        else { z[i][0] = __uint_as_float(XS[i].x); z[i][1] = __uint_as_float(XS[i].y); z[i][2] = __uint_as_float(XS[i].z); z[i][3] = __uint_as_float(XS[i].w);
               z[i][4] = __uint_as_float(CG[i].x); z[i][5] = __uint_as_float(CG[i].y); z[i][6] = __uint_as_float(CG[i].z); z[i][7] = __uint_as_float(CG[i].w); } }
#pragma unroll
    for (int i = 0; i < 4; ++i) { const int r = r0 + i; float bg[8], o[8]; unpack8(BG[i], bg);
#pragma unroll
        for (int e = 0; e < 8; ++e) o[e] = bg[e] * (w0[e] * z[i][e] + w1[e] * z[i + 1][e] + w2[e] * z[i + 2][e]);
        u32x4 w; w.x = pk_bf16(o[0], o[1]); w.y = pk_bf16(o[2], o[3]); w.z = pk_bf16(o[4], o[5]); w.w = pk_bf16(o[6], o[7]);
        *(u32x4*)(MIX + (size_t)(t.g0 + r) * DM + 512 + c8) = w;
        if (t.last && r >= t.R - 2) store8f(osc + (size_t)(r - (t.R - 2)) * 256 + c8, z[i + 2]); }
}

template <int R>
__device__ __forceinline__ void mix_mlp(const Params& p, int l, const Tile t, const bf16_t* P, bf16_t* MIX, LAS unsigned char* lds, int tid) {
    LAS unsigned* vs32 = (LAS unsigned*)lds;
    const LAS bf16_t* vs = (const LAS bf16_t*)lds;
    const int lane = tid & 63, wave = tid >> 6;
    constexpr int NIT = R * 32 / 512;
    {
        u32x4 V[NIT];
#pragma unroll
        for (int i = 0; i < NIT; ++i) { const int idx = tid + 512 * i, r = idx >> 5, c8 = (idx & 31) * 8; V[i] = *(const u32x4*)(P + (size_t)(t.g0 + r) * DP + PC_V + c8); }
#pragma unroll
        for (int i = 0; i < NIT; ++i) { const int idx = tid + 512 * i, r = idx >> 5, c8 = (idx & 31) * 8;
            LAS unsigned* d = vs32 + r * 129 + (c8 >> 1); d[0] = V[i].x; d[1] = V[i].y; d[2] = V[i].z; d[3] = V[i].w;
            if (R == 32) { float f[8]; unpack8(V[i], f); store8f(p.out + O_VS + ((size_t)(l * NBS + t.b) * 32 + r) * 256 + c8, f); } }
    }
    const int h = wave >> 1, rh = wave & 1, fr = lane & 15, fq = lane >> 4;
    constexpr int MMAX = (R == 128) ? 4 : 2, KMAX = (R == 128) ? 4 : 1;
    const int kmax = (R == 128) ? 2 * (rh + 1) : 1;
    const bool active = (R == 128 || rh == 0);
    bf16x8 af[KMAX][MMAX]; u32x2 uu[MMAX][4]; float bias[MMAX];
    if (active) {
        const bf16_t* WST = (const bf16_t*)(p.ws + WS_WST) + (size_t)(l * 4 + h) * 128 * 128;
#pragma unroll
        for (int k = 0; k < KMAX; ++k)
#pragma unroll
            for (int m = 0; m < MMAX; ++m) af[k][m] = (k < kmax) ? *(const bf16x8*)(WST + (size_t)(64 * rh + 16 * m + fr) * 128 + 32 * k + 8 * fq) : (bf16x8){0, 0, 0, 0, 0, 0, 0, 0};
#pragma unroll
        for (int m = 0; m < MMAX; ++m) { const int i = 64 * rh + 16 * m + fr; bias[m] = ((const float*)(p.ws + WS_SMALL))[SP_BS + (l * 4 + h) * 128 + i];
#pragma unroll
            for (int n = 0; n < 4; ++n) uu[m][n] = *(const u32x2*)(P + (size_t)(t.g0 + i) * DP + PC_U + 64 * h + 16 * n + 4 * fq); }
    }
    WG_BAR();
    if (active) {
        f32x4 acc[MMAX][4];
#pragma unroll
        for (int m = 0; m < MMAX; ++m)
#pragma unroll
            for (int n = 0; n < 4; ++n) acc[m][n] = (f32x4){0.f, 0.f, 0.f, 0.f};
#pragma unroll
        for (int k = 0; k < KMAX; ++k) {
            if (k < kmax) {
                bf16x8 bf[4];
#pragma unroll
                for (int n = 0; n < 4; ++n)
#pragma unroll
                    for (int i = 0; i < 8; ++i) bf[n][i] = (short)vs[(32 * k + 8 * fq + i) * 258 + 64 * h + 16 * n + fr];
#pragma unroll
                for (int m = 0; m < MMAX; ++m)
#pragma unroll
                    for (int n = 0; n < 4; ++n) acc[m][n] = __builtin_amdgcn_mfma_f32_16x16x32_bf16(bf[n], af[k][m], acc[m][n], 0, 0, 0);
            }
        }
#pragma unroll
        for (int m = 0; m < MMAX; ++m) {
            const int i = 64 * rh + 16 * m + fr;
#pragma unroll
            for (int n = 0; n < 4; ++n) { const int d = 64 * h + 16 * n + 4 * fq;
                const float o0 = bf_lo(uu[m][n].x) * (acc[m][n][0] + bias[m]), o1 = bf_hi(uu[m][n].x) * (acc[m][n][1] + bias[m]), o2 = bf_lo(uu[m][n].y) * (acc[m][n][2] + bias[m]), o3 = bf_hi(uu[m][n].y) * (acc[m][n][3] + bias[m]);
                u32x2 o; o.x = pk_bf16(o0, o1); o.y = pk_bf16(o2, o3);
                *(u32x2*)(MIX + (size_t)(t.g0 + i) * DM + 768 + d) = o; }
        }
    }
    WG_BAR();
}


__device__ __forceinline__ void conv_loads(const Tile t, const bf16_t* P, int tid, u32x4 (&A)[6]) {
    const bool hist = (t.t0 != 0);
#pragma unroll
    for (int i = 0; i < 6; ++i) { const int idx = tid + 512 * i, rr = idx >> 5, c8 = (idx & 31) * 8, rrel = rr - 30;
        A[i] = (u32x4){0u, 0u, 0u, 0u};
        if (idx < 94 * 32 && (rrel >= 0 || hist)) A[i] = *(const u32x4*)(P + (size_t)(t.g0 + rrel) * DP + PC_Z + c8); }
}
__device__ __forceinline__ int mix_conv_run(const Params& p, int l, const bf16_t* P, bf16_t* MIX, LAS unsigned char* lds, int tid, int u, const int stride, const int uend) {
    LAS float* z = (LAS float*)lds; LAS float* st = (LAS float*)(lds + 94 * 256 * 4);
    const float* SP = (const float*)(p.ws + WS_SMALL);
    const int lane = tid & 63, wave = tid >> 6, c = tid & 255, half = tid >> 8;
    float w[31];
#pragma unroll
    for (int k = 0; k < 31; ++k) w[k] = SP[SP_WDW + (l * 31 + k) * 256 + c];
    const float bias = SP[SP_BDW + l * 256 + c], lg = SP[SP_LNG + l * 256 + c], lb = SP[SP_LNB + l * 256 + c];
    Tile t = prompt_tile(u, 64);
    u32x4 A[6]; conv_loads(t, P, tid, A);
    for (;;) {
        float* oconv = p.out + O_CONVP + (size_t)(l * NBP + t.b) * 30 * 256;
#pragma unroll
        for (int i = 0; i < 6; ++i) { const int idx = tid + 512 * i, rr = idx >> 5, c8 = (idx & 31) * 8, rrel = rr - 30;
            if (idx < 94 * 32) { float zz[8]; unpack8(A[i], zz);
                *(LAS f32x4*)(z + rr * 256 + c8) = (f32x4){zz[0], zz[1], zz[2], zz[3]}; *(LAS f32x4*)(z + rr * 256 + c8 + 4) = (f32x4){zz[4], zz[5], zz[6], zz[7]};
                if (t.last && rrel >= 34) store8f(oconv + (size_t)(rrel - 34) * 256 + c8, zz); } }
        WG_BAR();
        const int un = u + stride; const bool hn = un < uend; const Tile tn = prompt_tile(hn ? un : u, 64);
        if (hn) conv_loads(tn, P, tid, A);
        float cv[4][8];
#pragma unroll
        for (int blk = 0; blk < 4; ++blk) conv_block(z, st, w, bias, half * 32 + blk * 8, c, lane, wave & 3, cv[blk]);
        WG_BAR();
#pragma unroll
        for (int blk = 0; blk < 4; ++blk) { const int r0 = half * 32 + blk * 8; conv_norm(st, cv[blk], r0, lg, lb, MIX + (size_t)(t.g0 + r0) * DM + 256 + c); }
        WG_BAR();
        u = un; if (!hn) break; t = tn;
    }
    return u;
}
__device__ __forceinline__ void pool_loads(const Tile t, const bf16_t* P, int tid, u32x4 (&A)[5]) {
    const bool hist = (t.t0 != 0);
#pragma unroll
    for (int i = 0; i < 5; ++i) { const int idx = tid + 512 * i, rr = idx >> 5, c8 = (idx & 31) * 8, rrel = rr - 15;
        A[i] = (u32x4){0u, 0u, 0u, 0u};
        if (idx < 79 * 32 && (rrel >= 0 || hist)) A[i] = *(const u32x4*)(P + (size_t)(t.g0 + rrel) * DP + c8); }
}
__device__ __forceinline__ int mix_pool_run(const Params& p, int l, const bf16_t* P, bf16_t* MIX, LAS unsigned char* lds, int tid, int u, const int stride, const int uend) {
    LAS float* xs = (LAS float*)lds; LAS bf16_t* pre = (LAS bf16_t*)(lds + 79 * 256 * 4);
    const int lane = tid & 63, wave = tid >> 6, g = wave >> 1, rh = wave & 1, fr = lane & 15, fq = lane >> 4;
    bf16x8 bf[4][2];
    {
        const bf16_t* WPT = (const bf16_t*)(p.ws + WS_WPT) + (size_t)(l * 4 + g) * 64 * 64;
#pragma unroll
        for (int n = 0; n < 4; ++n)
#pragma unroll
            for (int k = 0; k < 2; ++k) bf[n][k] = *(const bf16x8*)(WPT + (16 * n + fr) * 64 + 32 * k + 8 * fq);
    }
    const int c = tid & 255, half = tid >> 8, gg = c >> 6, w = 2 << gg;
    float mk[16];
#pragma unroll
    for (int j = 0; j < 16; ++j) mk[j] = (j < w) ? 1.0f : 0.0f;
    Tile t = prompt_tile(u, 64);
    u32x4 A[5]; pool_loads(t, P, tid, A);
    for (;;) {
        float* opool = p.out + O_POOLP + (size_t)(l * NBP + t.b) * 15 * 256;
#pragma unroll
        for (int i = 0; i < 5; ++i) { const int idx = tid + 512 * i, rr = idx >> 5, c8 = (idx & 31) * 8, rrel = rr - 15;
            if (idx < 79 * 32) { float v[8]; unpack8(A[i], v);
                *(LAS f32x4*)(xs + rr * 256 + c8) = (f32x4){v[0], v[1], v[2], v[3]}; *(LAS f32x4*)(xs + rr * 256 + c8 + 4) = (f32x4){v[4], v[5], v[6], v[7]};
                if (t.last && rrel >= 49) store8f(opool + (size_t)(rrel - 49) * 256 + c8, v); } }
        WG_BAR();
        const int un = u + stride; const bool hn = un < uend; const Tile tn = prompt_tile(hn ? un : u, 64);
        if (hn) pool_loads(tn, P, tid, A);
        for (int r0 = half * 32; r0 < (half + 1) * 32; r0 += 4) {
            float v[19];
#pragma unroll
            for (int i = 0; i < 19; ++i) v[i] = xs[(r0 + i) * 256 + c];
#pragma unroll
            for (int q = 0; q < 4; ++q) { float sm = 0.f;
#pragma unroll
                for (int j = 0; j < 16; ++j) sm += mk[j] * v[q + 15 - j];
                const int pos = t.t0 + r0 + q; const float cnt = (float)((pos + 1 < w) ? pos + 1 : w);
                const float pv = sm * __builtin_amdgcn_rcpf(cnt) - v[q + 15];
                pre[(r0 + q) * 264 + c] = (bf16_t)(pk_bf16(pv, 0.f) & 0xffffu); }
        }
        WG_BAR();
#pragma unroll
        for (int m = 0; m < 2; ++m) {
            const int row = rh * 32 + 16 * m + fr;
            bf16x8 af[2];
#pragma unroll
            for (int k = 0; k < 2; ++k) af[k] = *(const LAS bf16x8*)(pre + row * 264 + g * 64 + 32 * k + 8 * fq);
#pragma unroll
            for (int n = 0; n < 4; ++n) { f32x4 a = {0.f, 0.f, 0.f, 0.f};
#pragma unroll
                for (int k = 0; k < 2; ++k) a = __builtin_amdgcn_mfma_f32_16x16x32_bf16(bf[n][k], af[k], a, 0, 0, 0);
                u32x2 o; o.x = pk_bf16(a[0], a[1]); o.y = pk_bf16(a[2], a[3]);
                *(u32x2*)(MIX + (size_t)(t.g0 + row) * DM + g * 64 + 16 * n + 4 * fq) = o; }
        }
        WG_BAR();
        u = un; if (!hn) break; t = tn;
    }
    return u;
}

constexpr int NU_CONV = MP / 64, NU_POOL = MP / 64, NU_MLP = MP / 128, NU_SC = MP / 64, NU_PROMPT = NU_CONV + NU_POOL + NU_MLP + NU_SC, NU_ALL = NU_PROMPT + 4 * NBS;
__device__ __forceinline__ void mixer_phase(const Params& p, int l, LAS unsigned char* lds, int tid, const int first, const int stride, const int mask = EXP_MIXMASK) {
    const bf16_t* P = (const bf16_t*)(p.ws + WS_P); bf16_t* MIX = (bf16_t*)(p.ws + WS_MIX);
    int u = first;
    asm volatile("" : "+v"(tid));
    if (u < NU_CONV) { const int un = mix_conv_run(p, l, P, MIX, lds, tid, u, stride, NU_CONV); u = un; }
    asm volatile("" : "+v"(tid));
    if (u < NU_CONV + NU_POOL) { const int un = mix_pool_run(p, l, P, MIX, lds, tid, u - NU_CONV, stride, NU_POOL); u = un + NU_CONV; }
    for (; u < NU_PROMPT; u += stride) {
        int r = u - NU_CONV - NU_POOL; asm volatile("" : "+v"(tid));
        {
            const int rn = r + stride;
            if (rn < NU_MLP) { const Tile tn = prompt_tile(rn, 128); const bf16_t* q = P + (size_t)(tn.g0 + (tid >> 2)) * DP + 64 * (tid & 3);
                (void)*(volatile const unsigned*)(q + PC_V); (void)*(volatile const unsigned*)(q + PC_U); }
            else if (rn < NU_MLP + NU_SC) { const Tile tn = prompt_tile(rn - NU_MLP, 64); const int rr = (tid >> 2) - 2;
                if (rr < 64 && (rr >= 0 || tn.t0 != 0)) (void)*(volatile const unsigned*)(P + (size_t)(tn.g0 + rr) * DP + PC_ZS + 64 * (tid & 3));
                if (rr >= 0 && rr < 64) (void)*(volatile const unsigned*)(P + (size_t)(tn.g0 + rr) * DP + PC_B + 64 * (tid & 3)); }
        }
        if (r < NU_MLP) { if (mask & 4) mix_mlp<128>(p, l, prompt_tile(r, 128), P, MIX, lds, tid); continue; } r -= NU_MLP;
        if (mask & 8) mix_sconv(p, l, prompt_tile(r, 64), P, MIX, tid);
    }
}
__device__ __forceinline__ void sample_mixers(const Params& p, int l, LAS unsigned char* lds, int tid, const int first, const int stride) {
    const bf16_t* P = (const bf16_t*)(p.ws + WS_P); bf16_t* MIX = (bf16_t*)(p.ws + WS_MIX);
    for (int r = first; r < 4 * NBS; r += stride) {
        asm volatile("" : "+v"(tid));
        const int b = r & 7, kind = r >> 3;
        if (kind == 0) mix_conv(p, l, sample_tile(b), P, MIX, lds, tid);
        else if (kind == 1) mix_pool(p, l, sample_tile(b), P, MIX, lds, tid);
        else if (kind == 2) mix_mlp<32>(p, l, sample_tile(b), P, MIX, lds, tid);
        else mix_sconv(p, l, sample_tile(b), P, MIX, tid);
    }
}

__device__ __forceinline__ void final_norm(const Params& p, int lane, int wave, const int gw, const int NGW, const int row_lo, const int row_hi) {
    const bf16_t* XB = (const bf16_t*)(p.ws + WS_XB); const float* SSQ = (const float*)(p.ws + WS_SSQA);
    f32x4 g[4];
#pragma unroll
    for (int j = 0; j < 4; ++j) g[j] = ((const f32x4*)(p.ws + WS_SMALL + (size_t)SP_GF * 4))[lane + 64 * j];
    for (int m0 = row_lo + gw; m0 < row_hi; m0 += 4 * NGW) {
        u32x2 v[4][4]; float s[4];
#pragma unroll
        for (int h = 0; h < 4; ++h) { const int m = m0 + h * NGW; const int mm = m < row_hi ? m : m0; const u32x2* xr = (const u32x2*)(XB + (size_t)mm * DM) + lane;
#pragma unroll
            for (int j = 0; j < 4; ++j) v[h][j] = xr[64 * j];
            s[h] = (lane < 16) ? SSQ[(size_t)mm * 16 + lane] : 0.f; }
#pragma unroll
        for (int h = 0; h < 4; ++h) { const int m = m0 + h * NGW; const float rs = rsqrtf(wave_sum(s[h]) * (1.0f / DM) + EPS);
            if (m < row_hi) { f32x4* o = (f32x4*)(p.out + (size_t)m * DM) + lane;
#pragma unroll
                for (int j = 0; j < 4; ++j) { const f32x4 x = {bf_lo(v[h][j].x), bf_hi(v[h][j].x), bf_lo(v[h][j].y), bf_hi(v[h][j].y)}; __builtin_nontemporal_store(x * rs * g[j], &o[64 * j]); } } }
    }
}

#define XB_TMO      128
#define XB_XCNT(j)  (256  + 64 * (j))
#define XB_XSUB(j)  (1280 + 64 * (j))
#define XB_XGEN(j)  (2304 + 64 * (j))
#define XB_TOP      3328
#define XB_TOPGEN   3392
#define XCD_BAR_WORDS 3456
#define XB_SPIN_CAP (1u << 18)

__device__ __forceinline__ unsigned xb_ld(unsigned* p)              { return __hip_atomic_load(p, __ATOMIC_RELAXED, __HIP_MEMORY_SCOPE_AGENT); }
__device__ __forceinline__ unsigned xb_add(unsigned* p, unsigned v) { return __hip_atomic_fetch_add(p, v, __ATOMIC_RELAXED, __HIP_MEMORY_SCOPE_AGENT); }
__device__ __forceinline__ unsigned xb_xcc_id() { return (unsigned)__builtin_amdgcn_s_getreg((3 << 11) | 20) & 0xFu; }
#define XB_SPIN(cond, bar) do { unsigned _sp = 0; while (cond) { __builtin_amdgcn_s_sleep(1); \
    if ((++_sp & 255u) == 0u) { if (xb_ld(&(bar)[XB_TMO])) break; if (_sp > XB_SPIN_CAP) { atomicAdd(&(bar)[XB_TMO], 1u); break; } } } } while (0)

struct XcdBarrier {
    unsigned* bar; unsigned x;
    volatile LAS unsigned* st;
};

__device__ __forceinline__ XcdBarrier xcd_barrier_post(unsigned* bar, volatile LAS unsigned* st) {
    XcdBarrier b; b.bar = bar; b.x = xb_xcc_id(); b.st = st;
    if (threadIdx.x == 0) (void)xb_add(&bar[XB_XCNT(b.x)], 1u);
    return b;
}
__device__ __forceinline__ void xcd_barrier_complete(unsigned* bar, unsigned x, unsigned& nloc, unsigned& nx) {
    const unsigned G = gridDim.x * gridDim.y * gridDim.z;
    unsigned sum, cnt, mine, sp = 0u;
    for (;;) {
        sum = 0u; cnt = 0u; mine = 0u;
#pragma unroll
        for (unsigned j = 0; j < 16; ++j) { const unsigned c = xb_ld(&bar[XB_XCNT(j)]); sum += c; cnt += (c > 0u) ? 1u : 0u; mine = (j == x) ? c : mine; }
        if (sum == G) break;
        __builtin_amdgcn_s_sleep(1);
        if ((++sp & 255u) == 0u) { if (xb_ld(&bar[XB_TMO])) break; if (sp > XB_SPIN_CAP) { atomicAdd(&bar[XB_TMO], 1u); break; } }
    }
    nloc = mine > 0u ? mine : 1u; nx = cnt > 0u ? cnt : 1u;
}

__device__ __forceinline__ void xcd_barrier(const XcdBarrier& b) {
    asm volatile("s_waitcnt vmcnt(0)" ::: "memory");
    __syncthreads();
    if (pg8::pg8_tid((LAS unsigned char*)b.st - 131072) == 0) {
        unsigned* bar = b.bar;
        __builtin_amdgcn_s_waitcnt(0);
        unsigned nloc = b.st[0], nx = b.st[1];
        if (nloc == 0u) { xcd_barrier_complete(bar, b.x, nloc, nx); b.st[0] = nloc; b.st[1] = nx; }
        const unsigned old = xb_add(&bar[XB_XSUB(b.x)], 1u);
        const unsigned gen = old / nloc;
        if (old + 1u == (gen + 1u) * nloc) {
            __builtin_amdgcn_fence(__ATOMIC_RELEASE, "agent");
            asm volatile("s_waitcnt vmcnt(0)" ::: "memory");
            const unsigned og = xb_add(&bar[XB_TOP], 1u);
            const unsigned tg = og / nx;
            if (og + 1u == (tg + 1u) * nx) xb_add(&bar[XB_TOPGEN], 1u);
            else XB_SPIN(xb_ld(&bar[XB_TOPGEN]) == tg, bar);
            __builtin_amdgcn_fence(__ATOMIC_ACQUIRE, "agent");
            xb_add(&bar[XB_XGEN(b.x)], 1u);
            asm volatile("s_waitcnt vmcnt(0)" ::: "memory");
        } else {
            XB_SPIN(xb_ld(&bar[XB_XGEN(b.x)]) == gen, bar);
            __builtin_amdgcn_fence(__ATOMIC_ACQUIRE, "agent");
            asm volatile("s_waitcnt vmcnt(0)" ::: "memory");
        }
    }
    __syncthreads();
}


constexpr int NSG = 22;
struct SampleOrder {
    int nN, c;
    __device__ __forceinline__ bool next(int i, pg8::Unit& u) const { const int j = i * NSG + c; if (j >= nN) return false; u.pm = MP / 256; u.pn = j; return true; }
    __device__ __forceinline__ void a_ready(const pg8::Unit&) const {}
    __device__ __forceinline__ void done(const pg8::Unit&) const {}
};
__device__ __forceinline__ void group_barrier(unsigned* ctr, unsigned target, unsigned* tmo, int tid) {
    asm volatile("s_waitcnt vmcnt(0)" ::: "memory");
    __syncthreads();
    if (tid == 0) {
        __builtin_amdgcn_fence(__ATOMIC_RELEASE, "agent");
        asm volatile("s_waitcnt vmcnt(0)" ::: "memory");
        (void)__hip_atomic_fetch_add(ctr, 1u, __ATOMIC_RELAXED, __HIP_MEMORY_SCOPE_AGENT);
        unsigned sp = 0;
        while (__hip_atomic_load(ctr, __ATOMIC_RELAXED, __HIP_MEMORY_SCOPE_AGENT) < target) { __builtin_amdgcn_s_sleep(1);
            if ((++sp & 255u) == 0u) { if (__hip_atomic_load(tmo, __ATOMIC_RELAXED, __HIP_MEMORY_SCOPE_AGENT)) break; if (sp > (1u << 20)) { atomicAdd(tmo, 1u); break; } } }
        __builtin_amdgcn_fence(__ATOMIC_ACQUIRE, "agent");
        asm volatile("s_waitcnt vmcnt(0)" ::: "memory");
    }
    __syncthreads();
}


struct EpiSwiGLUS {
    static constexpr bool PERM = true, AFTER_DRAIN = false;
    bf16_t* H; const float* ssq;
    __device__ __forceinline__ void operator()(const f32x4 (&acc)[2][2][4][2], const pg8::Unit& u, int wr, int wc, int fr, int fq) const {
        asm volatile("" : "+v"(fr));
        const int row0 = u.pm * 256 + wr * 64 + fr, lrow0 = wr * 64 + fr, kh = u.pn / 11, col0 = (u.pn - 11 * kh) * 128 + wc * 32 + 8 * fq;
        bf16_t* Hh = H + (size_t)kh * MS * KH;
#pragma unroll
        for (int ai = 0; ai < 2; ++ai)
#pragma unroll
            for (int m = 0; m < 4; ++m) {
                const int row = row0 + ai * 128 + m * 16; const float rs = row_rstd(ssq, row, fq);
                float h[8];
                const float c1 = rs * -1.4426950408889634f, rs2 = rs * rs;
#pragma unroll
                for (int n = 0; n < 2; ++n)
#pragma unroll
                    for (int j = 0; j < 4; j += 2) { const f32x2 ag = {acc[ai][0][m][n][j], acc[ai][0][m][n][j + 1]}, au = {acc[ai][1][m][n][j], acc[ai][1][m][n][j + 1]};
                        const f32x2 t = ag * c1; f32x2 e; e.x = __builtin_amdgcn_exp2f(t.x); e.y = __builtin_amdgcn_exp2f(t.y);
                        const f32x2 d = e + 1.0f; f32x2 r; r.x = __builtin_amdgcn_rcpf(d.x); r.y = __builtin_amdgcn_rcpf(d.y);
                        const f32x2 hh = (ag * au) * (r * rs2); h[n * 4 + j] = hh.x; h[n * 4 + j + 1] = hh.y; }
                u32x4 w; w.x = pk_bf16(h[0], h[1]); w.y = pk_bf16(h[2], h[3]); w.z = pk_bf16(h[4], h[5]); w.w = pk_bf16(h[6], h[7]);
                *(u32x4*)(Hh + (size_t)(lrow0 + ai * 128 + m * 16) * KH + col0) = w;
            }
    }
};
struct EpiPart {
    static constexpr bool PERM = false, AFTER_DRAIN = false;
    float* part;
    __device__ __forceinline__ void operator()(const f32x4 (&acc)[2][2][4][2], const pg8::Unit& u, int wr, int wc, int fr, int fq) const {
        asm volatile("" : "+v"(fr));
        const int lrow0 = wr * 64 + fr, col0 = u.pn * 256 + wc * 32 + 4 * fq;
#pragma unroll
        for (int ai = 0; ai < 2; ++ai)
#pragma unroll
            for (int m = 0; m < 4; ++m)
#pragma unroll
                for (int bj = 0; bj < 2; ++bj)
#pragma unroll
                    for (int n = 0; n < 2; ++n) *(f32x4*)(part + (size_t)(lrow0 + ai * 128 + m * 16) * DM + col0 + bj * 128 + n * 16) = acc[ai][bj][m][n];
    }
};
struct SampleOrderD {
    int c;
    __device__ __forceinline__ bool next(int i, pg8::Unit& u) const { if (i > 0 || c >= 8) return false; u.pm = 0; u.pn = c & 3; return true; }
    __device__ __forceinline__ void a_ready(const pg8::Unit&) const {}
    __device__ __forceinline__ void done(const pg8::Unit&) const {}
};
__device__ __forceinline__ void sample_combine(const Params& p, int lane, int gw, int NGW, float* ssq) {
    bf16_t* XB = (bf16_t*)(p.ws + WS_XB) + (size_t)MP * DM; const float* P0 = (const float*)(p.ws + WS_PART); const float* P1 = P0 + (size_t)MS * DM;
    for (int r = gw; r < MS; r += NGW) {
        u32x2* xr = (u32x2*)(XB + (size_t)r * DM) + lane; const f32x4* a = (const f32x4*)(P0 + (size_t)r * DM) + lane; const f32x4* b = (const f32x4*)(P1 + (size_t)r * DM) + lane;
        float q = 0.f;
#pragma unroll
        for (int j = 0; j < 4; ++j) { const u32x2 w = xr[64 * j]; const f32x4 x = (f32x4){bf_lo(w.x), bf_hi(w.x), bf_lo(w.y), bf_hi(w.y)} + a[64 * j] + b[64 * j];
            q += (x[0] * x[0] + x[1] * x[1]) + (x[2] * x[2] + x[3] * x[3]); u32x2 o; o.x = pk_bf16(x[0], x[1]); o.y = pk_bf16(x[2], x[3]); xr[64 * j] = o; }
        q = wave_sum(q);
        if (lane < 16) ssq[(size_t)(MP + r) * 16 + lane] = (lane == 0) ? q : 0.f;
    }
}


__global__ void __launch_bounds__(512, 2) fwd_megakernel(Params p) {
    extern __shared__ __attribute__((aligned(16))) unsigned char lds_raw[];
    LAS unsigned char* lds = (LAS unsigned char*)lds_raw;
    const int G = gridDim.x, bx = blockIdx.x;
#define MYTID() pg8::pg8_tid(lds)
#define LWS(name) size_t name##_z = 0; asm volatile("" : "+s"(name##_z)); unsigned char* name = p.ws + name##_z
#define SAMPLE_DOWN(L) do { \
            { LWS(ws); const int kh = (bx >> 2) & 1; \
              pg8::Gemm g{(const bf16_t*)(ws + WS_HIDS) + (size_t)kh * MS * KH, (const bf16_t*)(ws + WS_WDNS) + (size_t)((L) * 2 + kh) * DM * KH, MS, DM, KH}; SampleOrderD S{bx}; \
              EpiPart E{(float*)(ws + WS_PART) + (size_t)kh * MS * DM}; pg8::gemm_phase<EpiPart, SampleOrderD, true, true>(lds, g, S, E); } \
            { LWS(ws); group_barrier((unsigned*)(ws + WS_CTL) + 3584, NSG * (++ep), (unsigned*)(ws + WS_CTL) + 3648, MYTID()); } \
            { LWS(ws); const int t_ = MYTID(); sample_combine(p, t_ & 63, bx * 8 + (t_ >> 6), NSG * 8, (float*)(ws + WS_SSQA)); } } while (0)
#define GRID_SYNC() do { XcdBarrier b_ = bar; asm volatile("" : "+s"(b_.x)); LWS(w_); b_.bar = (unsigned*)(w_ + WS_CTL); xcd_barrier(b_); } while (0)
    { const int tid0 = threadIdx.x; volatile LAS unsigned* stw = (volatile LAS unsigned*)(lds + 131072); if (tid0 < 64) stw[tid0] = 0u;
      if (tid0 < 8) ((volatile LAS int*)(lds + LDS_RC + 4096))[tid0] = 0;
      if ((tid0 & 63) == 0) ((volatile LAS int*)(lds + 131072 + 256))[(int)__builtin_amdgcn_s_getreg((5 << 11) | 4) & 63] = tid0 >> 6; }
    __syncthreads();
    XcdBarrier bar = xcd_barrier_post((unsigned*)(p.ws + WS_CTL), (volatile LAS unsigned*)(lds + 131072));
    cg::this_grid().sync();
    { const int t_ = MYTID(); prologue(p, lds, t_, t_ & 63, t_ >> 6); convert_rows(p, t_ & 63, bx * 8 + (t_ >> 6), G * 8, MP, MT); }
    GRID_SYNC();
    constexpr int NI0 = DIN / 256;
    if (bx >= NI0) { int t_ = MYTID(); asm volatile("" : "+v"(t_)); convert_rows(p, t_ & 63, (bx - NI0) * 8 + (t_ >> 6), (G - NI0) * 8, 0, MP); }
    else { LWS(ws); pg8::Gemm g{(const bf16_t*)(ws + WS_XB), (const bf16_t*)(ws + WS_WIN), MT, DIN, DM}; SampleOrder S{DIN / 256, bx}; EpiInProj E{(bf16_t*)(ws + WS_P), (const float*)(ws + WS_SSQA), (LAS float*)(lds + LDS_RC), 9};
      pg8::gemm_phase<EpiInProj, SampleOrder, true, true>(lds, g, S, E); }
    GRID_SYNC();
#pragma unroll 1
    for (int l = 0; l < 2; ++l) {
        {
            LWS(ws);
            pg8::Gemm g{(const bf16_t*)(ws + WS_XB), (const bf16_t*)(ws + WS_WIN) + (size_t)l * DIN * DM, MP, DIN, DM}; pg8::StaticOrder S; S.init(MP, DIN, G, bx);
            EpiInProj E{(bf16_t*)(ws + WS_P), (const float*)(ws + WS_SSQA), (LAS float*)(lds + LDS_RC), 1 + 2 * l};
            pg8::gemm_phase<EpiInProj, pg8::StaticOrder, true, true>(lds, g, S, E);
        }
        GRID_SYNC();
        if (bx >= NSG) mixer_phase(p, l, lds, MYTID(), bx - NSG, G - NSG);
        else {
            unsigned ep = 4u * (unsigned)l;
            if (l == 1) {
              { LWS(ws); pg8::Gemm g{(const bf16_t*)(ws + WS_XB), (const bf16_t*)(ws + WS_WIN) + (size_t)DIN * DM, MT, DIN, DM}; SampleOrder S{DIN / 256, bx}; EpiInProj E{(bf16_t*)(ws + WS_P), (const float*)(ws + WS_SSQA), (LAS float*)(lds + LDS_RC), 10};
                pg8::gemm_phase<EpiInProj, SampleOrder, true, true>(lds, g, S, E); }
              { LWS(ws); group_barrier((unsigned*)(ws + WS_CTL) + 3584, NSG * (++ep), (unsigned*)(ws + WS_CTL) + 3648, MYTID()); }
            }
            sample_mixers(p, l, lds, MYTID(), bx, NSG);
            { LWS(ws); group_barrier((unsigned*)(ws + WS_CTL) + 3584, NSG * (++ep), (unsigned*)(ws + WS_CTL) + 3648, MYTID()); }
            { LWS(ws); pg8::Gemm g{(const bf16_t*)(ws + WS_MIX), (const bf16_t*)(ws + WS_WOUT) + (size_t)l * DM * DM, MT, DM, DM}; SampleOrder S{DM / 256, bx};
              EpiResid E{nullptr, (bf16_t*)(ws + WS_XB), (float*)(ws + WS_SSQB)}; pg8::gemm_phase<EpiResid, SampleOrder, true, true>(lds, g, S, E); }
            { LWS(ws); group_barrier((unsigned*)(ws + WS_CTL) + 3584, NSG * (++ep), (unsigned*)(ws + WS_CTL) + 3648, MYTID()); }
            { LWS(ws); pg8::Gemm g{(const bf16_t*)(ws + WS_XB), (const bf16_t*)(ws + WS_WGU) + (size_t)l * NGU * DM, MT, NGU, DM}; SampleOrder S{NGU / 256, bx};
              EpiSwiGLUS E{(bf16_t*)(ws + WS_HIDS), (const float*)(ws + WS_SSQB)}; pg8::gemm_phase<EpiSwiGLUS, SampleOrder, true, true>(lds, g, S, E); }
            if (l == 0) {
                { LWS(ws); group_barrier((unsigned*)(ws + WS_CTL) + 3584, NSG * (++ep), (unsigned*)(ws + WS_CTL) + 3648, MYTID()); }
                SAMPLE_DOWN(0);
            }
        }
        GRID_SYNC();
        {
            LWS(ws);
            pg8::Gemm g{(const bf16_t*)(ws + WS_MIX), (const bf16_t*)(ws + WS_WOUT) + (size_t)l * DM * DM, MP, DM, DM}; pg8::StaticOrder S; S.init(MP, DM, G, bx);
            EpiResid E{nullptr, (bf16_t*)(ws + WS_XB), (float*)(ws + WS_SSQB)};
            pg8::gemm_phase<EpiResid, pg8::StaticOrder, true, true>(lds, g, S, E);
        }
        GRID_SYNC();
        {
            LWS(ws);
            pg8::Gemm g{(const bf16_t*)(ws + WS_XB), (const bf16_t*)(ws + WS_WGU) + (size_t)l * NGU * DM, MP, NGU, DM}; pg8::StaticOrder S; S.init(MP, NGU, G, bx);
            EpiSwiGLU E{(bf16_t*)(ws + WS_HID), (const float*)(ws + WS_SSQB), (LAS float*)(lds + LDS_RC), 2 + 2 * l};
            pg8::gemm_phase<EpiSwiGLU, pg8::StaticOrder, true, true>(lds, g, S, E);
        }
        GRID_SYNC();
        {
            LWS(ws);
            pg8::Gemm g{(const bf16_t*)(ws + WS_HID), (const bf16_t*)(ws + WS_WDN) + (size_t)l * DM * DFF, MP, DM, DFF}; pg8::StaticOrder S; S.init(MP, DM, G, bx);
            EpiResid E{nullptr, (bf16_t*)(ws + WS_XB), (float*)(ws + WS_SSQA)};
            pg8::gemm_phase<EpiResid, pg8::StaticOrder, true, true>(lds, g, S, E);
        }
        GRID_SYNC();
    }
    if (bx >= NSG) { int t2 = MYTID(); asm volatile("" : "+v"(t2)); final_norm(p, t2 & 63, t2 >> 6, (bx - NSG) * 8 + (t2 >> 6), (G - NSG) * 8, 0, MP); }
    else {
        unsigned ep = 7u;
        SAMPLE_DOWN(1);
        { LWS(ws); group_barrier((unsigned*)(ws + WS_CTL) + 3584, NSG * (++ep), (unsigned*)(ws + WS_CTL) + 3648, MYTID()); }
        { int t2 = MYTID(); asm volatile("" : "+v"(t2)); final_norm(p, t2 & 63, t2 >> 6, bx * 8 + (t2 >> 6), NSG * 8, MP, MT); }
    }
}

extern "C" void kernel_launch(void* const* d_in, const int* in_sizes, int n_in, void* d_out, int out_size, void* d_ws, size_t ws_size, hipStream_t stream) {
    static int grid = 0;
    if (grid == 0) {
        if ((size_t)out_size != O_END) fprintf(stderr, "kernel_launch: note: out_size %d, expected %zu\n", out_size, (size_t)O_END);
        if (n_in != 22 || in_sizes[0] != MP * DM || ws_size < WS_END) {
            fprintf(stderr, "kernel_launch: unexpected shapes: n_in %d in0 %d out %d ws %zu (need %zu)\n", n_in, n_in > 0 ? in_sizes[0] : -1, out_size, ws_size, (size_t)WS_END); grid = -1; return; }
        int dev = 0, cus = 0, per_cu = 0;
        (void)hipGetDevice(&dev); (void)hipDeviceGetAttribute(&cus, hipDeviceAttributeMultiprocessorCount, dev);
        if (hipFuncSetAttribute((const void*)fwd_megakernel, hipFuncAttributeMaxDynamicSharedMemorySize, LDS_BYTES) != hipSuccess) { fprintf(stderr, "kernel_launch: hipFuncSetAttribute failed\n"); grid = -1; return; }
        if (hipOccupancyMaxActiveBlocksPerMultiprocessor(&per_cu, (const void*)fwd_megakernel, 512, LDS_BYTES) != hipSuccess || per_cu < 1) { fprintf(stderr, "kernel_launch: occupancy query says %d blocks per CU\n", per_cu); per_cu = 1; }
        (void)hipGetLastError();
        grid = cus * per_cu;
    }
    if (grid < 0) return;
    if (hipMemsetAsync((char*)d_ws + WS_CTL, 0, CTL_BYTES, stream) != hipSuccess) { fprintf(stderr, "kernel_launch: memset failed\n"); return; }
    Params p{};
    const float** pp = (const float**)&p;
    for (int i = 0; i < 22; ++i) pp[i] = (const float*)d_in[i];
    p.out = (float*)d_out; p.ws = (unsigned char*)d_ws;
    void* args[] = {&p};
    hipError_t e = hipLaunchCooperativeKernel((const void*)fwd_megakernel, dim3(grid), dim3(512), args, LDS_BYTES, stream);
    if (e != hipSuccess) fprintf(stderr, "kernel_launch: cooperative launch failed: %s (grid %d)\n", hipGetErrorString(e), grid);
}
```

```cpp
#include <hip/hip_runtime.h>
#include <hip/hip_cooperative_groups.h>
#include <cstdio>
#include <cstdint>
namespace cg = cooperative_groups;
namespace pg8 {
#define PG8_LAS __attribute__((address_space(3)))
typedef unsigned short bf16_t;
typedef short bf16x8 __attribute__((ext_vector_type(8)));
typedef float f32x4 __attribute__((ext_vector_type(4)));
typedef unsigned u32x4 __attribute__((ext_vector_type(4)));
constexpr int BM = 256, BK = 64, HALF = 128, HTB = HALF * BK * 2  , STAGE_BYTES = 8 * HTB, NXCD = 8, WGM = 8;

__host__ __device__ __forceinline__ int lds_byte(int r, int c) { const int st = (r >> 4) * 2 + (c >> 5), rr = r & 15, cc = c & 31, ob = rr * 64 + cc * 2; return st * 1024 + (ob ^ (((ob >> 9) & 1) << 5)); }
__host__ __device__ __forceinline__ void stage_rc(int b, int& R, int& C) { const int st = b / 1024, sb = b % 1024, swz = sb ^ (((sb >> 9) & 1) << 5); R = (st >> 1) * 16 + swz / 64; C = (st & 1) * 32 + (swz % 64) / 2; }
__host__ __device__ __forceinline__ int perm32(int rho) { const int n = rho >> 4, i = rho & 15; return 8 * (i >> 2) + 4 * n + (i & 3); }

struct Unit { int pm, pn; };
struct Gemm { const bf16_t* A; const bf16_t* Bt; int M, N, K; };

struct StaticOrder {
    int nM, nN, nwg, G, c, wgm = WGM;
    __host__ __device__ void init(int M, int N, int G_, int c_) { nM = M / BM; nN = N / BM; nwg = nM * nN; G = G_; c = c_; }
    __host__ __device__ bool next(int i, Unit& u) const {
        const long L = (long)i * G + c; if (L >= nwg) return false;
        int wgid = (int)L; { const int q = nwg / NXCD, r = nwg % NXCD, xcd = wgid % NXCD, off = wgid / NXCD; wgid = (xcd < r ? xcd * (q + 1) : r * (q + 1) + (xcd - r) * q) + off; }
        const int nig = wgm * nN, gid = wgid / nig, fm = gid * wgm, gsz = (nM - fm) < wgm ? (nM - fm) : wgm;
        u.pm = fm + ((wgid % nig) % gsz); u.pn = (wgid % nig) / gsz; return true;
    }
    __device__ __forceinline__ void a_ready(const Unit&) const {}
    __device__ __forceinline__ void done(const Unit&) const {}
};
__device__ __forceinline__ unsigned cvt_pk_bf16(float lo, float hi) { unsigned r; asm volatile("v_cvt_pk_bf16_f32 %0, %1, %2" : "=v"(r) : "v"(lo), "v"(hi)); return r; }
typedef float f32x2 __attribute__((ext_vector_type(2)));
__device__ __forceinline__ int pg8_tid(PG8_LAS unsigned char* lds) {
    const int slot = (int)__builtin_amdgcn_s_getreg((5 << 11) | 4) & 63;
    const int w = ((volatile PG8_LAS int*)(lds + 131072 + 256))[slot];
    return __builtin_amdgcn_readfirstlane(w) * 64 + (int)__builtin_amdgcn_mbcnt_hi(~0u, __builtin_amdgcn_mbcnt_lo(~0u, 0u));
}
template <class Epi, class Sched, bool ALIGN_EPI = false, bool SP2 = false>
__device__ __forceinline__ void gemm_phase(PG8_LAS unsigned char* lds, const Gemm g, const Sched& S, const Epi& E) {
    int tid_l = pg8_tid(lds); asm volatile("" : "+v"(tid_l));
    const int tid = tid_l, wid = __builtin_amdgcn_readfirstlane(tid >> 6), lane = tid & 63, wr = wid >> 2, wc = wid & 3, fr = lane & 15, fq = lane >> 4;
    const int K = g.K, nt = K / BK;
    unsigned voffA[2], voffB[2];
#pragma unroll
    for (int i = 0; i < 2; ++i) { int R, C; stage_rc(tid * 16 + i * 8192, R, C); const int Rb = Epi::PERM ? ((R & ~31) + perm32(R & 31)) : R;
        voffA[i] = (unsigned)(R * K + C) * 2u; voffB[i] = (unsigned)(Rb * K + C) * 2u; }
    const size_t kstep = (size_t)(BK * 2);
    const size_t hstep = (size_t)HALF * K * 2;
    const size_t tstep = 2 * hstep;
    const unsigned ldsw = (unsigned)wid * 1024u;
    const int aoff = lds_byte(wr * 64 + fr, fq * 8), boff = lds_byte(wc * 32 + fr, fq * 8);
#define PG8_SA(b, h) (((b) * 2 + (h)) * HTB)
#define PG8_SB(b, h) ((4 + (b) * 2 + (h)) * HTB)
#define PG8_STAGE(bufoff, gbase, voff) do { _Pragma("unroll") for (int _i = 0; _i < 2; ++_i) \
        __builtin_amdgcn_global_load_lds((const unsigned*)((const char*)(gbase) + (voff)[_i]), (PG8_LAS unsigned*)(lds + (bufoff) + ldsw + _i * 8192), 16, 0, 0); } while (0)
#define PG8_LDA(dst, b, h) do { _Pragma("unroll") for (int m = 0; m < 4; ++m) _Pragma("unroll") for (int k = 0; k < 2; ++k) dst[m][k] = *(const PG8_LAS bf16x8*)(lds + PG8_SA(b, h) + aoff + m * 2048 + k * 1024); } while (0)
#define PG8_LDB(dst, b, h) do { _Pragma("unroll") for (int n = 0; n < 2; ++n) _Pragma("unroll") for (int k = 0; k < 2; ++k) dst[n][k] = *(const PG8_LAS bf16x8*)(lds + PG8_SB(b, h) + boff + n * 2048 + k * 1024); } while (0)
#define PG8_MMA(ai, bj, At, Bt) do { __builtin_amdgcn_s_setprio(1); _Pragma("unroll") for (int m = 0; m < 4; ++m) _Pragma("unroll") for (int n = 0; n < 2; ++n) _Pragma("unroll") for (int k = 0; k < 2; ++k) \
        acc[ai][bj][m][n] = __builtin_amdgcn_mfma_f32_16x16x32_bf16(Bt[n][k], At[m][k], acc[ai][bj][m][n], 0, 0, 0); __builtin_amdgcn_s_setprio(0); } while (0)
#define PG8_WAIT_V(n) asm volatile("s_waitcnt vmcnt(" #n ")" ::: "memory")
#define PG8_WAIT_L(n) asm volatile("s_waitcnt lgkmcnt(" #n ")" ::: "memory")
#define PG8_BAR __builtin_amdgcn_s_barrier()
#define PG8_SCHED __builtin_amdgcn_sched_barrier(0)
    Unit cur, nxt; int ui = 0;
    if (!S.next(0, cur)) return;
    f32x4 acc[2][2][4][2];
#pragma unroll
    for (int a = 0; a < 2; ++a)
#pragma unroll
        for (int b = 0; b < 2; ++b)
#pragma unroll
            for (int m = 0; m < 4; ++m)
#pragma unroll
                for (int n = 0; n < 2; ++n) acc[a][b][m][n] = (f32x4){0.f, 0.f, 0.f, 0.f};
    bf16x8 At[4][2], B0[2][2], B1[2][2];
    const char* cA = (const char*)g.A + (size_t)cur.pm * tstep; const char* cB = (const char*)g.Bt + (size_t)cur.pn * tstep;
    S.a_ready(cur);
    if constexpr (SP2) {
        PG8_STAGE(PG8_SB(0, 0), cB, voffB); PG8_STAGE(PG8_SB(0, 1), cB + hstep, voffB); PG8_STAGE(PG8_SA(0, 0), cA, voffA); PG8_STAGE(PG8_SA(0, 1), cA + hstep, voffA);
        if (wr == 1) PG8_BAR;
        PG8_WAIT_V(2); PG8_BAR;
        PG8_STAGE(PG8_SB(1, 0), cB + kstep, voffB); PG8_STAGE(PG8_SA(1, 0), cA + kstep, voffA); PG8_STAGE(PG8_SB(1, 1), cB + hstep + kstep, voffB);
        PG8_WAIT_V(6); PG8_BAR;
    } else {
        PG8_STAGE(PG8_SB(0, 0), cB, voffB); PG8_STAGE(PG8_SA(0, 0), cA, voffA); PG8_STAGE(PG8_SB(0, 1), cB + hstep, voffB); PG8_STAGE(PG8_SA(0, 1), cA + hstep, voffA);
        if (wr == 1) PG8_BAR;
        PG8_WAIT_V(4); PG8_BAR;
        PG8_STAGE(PG8_SB(1, 0), cB + kstep, voffB); PG8_STAGE(PG8_SA(1, 0), cA + kstep, voffA); PG8_STAGE(PG8_SB(1, 1), cB + hstep + kstep, voffB);
        PG8_WAIT_V(6); PG8_BAR;
    }
    for (;;) {
        const bool has_next = S.next(ui + 1, nxt);
        const char* nA = has_next ? (const char*)g.A + (size_t)nxt.pm * tstep : cA; const char* nB = has_next ? (const char*)g.Bt + (size_t)nxt.pn * tstep : cB;
        for (int t = 0; t < nt; t += 2) {
            const bool last = (t == nt - 2);
            const char* a1 = cA + (size_t)(t + 1) * kstep;
            const char* a2 = last ? nA : cA + (size_t)(t + 2) * kstep; const char* b2 = last ? nB : cB + (size_t)(t + 2) * kstep;
            const char* a3 = a2 + kstep; const char* b3 = b2 + kstep;
            if (last && has_next) S.a_ready(nxt);
            if constexpr (SP2) {
            PG8_LDB(B0, 0, 0); PG8_LDB(B1, 0, 1); PG8_SCHED; PG8_LDA(At, 0, 0); PG8_STAGE(PG8_SA(1, 1), a1 + hstep, voffA);
            PG8_WAIT_V(8); PG8_WAIT_L(0); PG8_BAR; PG8_MMA(0, 0, At, B0); PG8_MMA(0, 1, At, B1); PG8_BAR; PG8_SCHED;
            PG8_LDA(At, 0, 1); PG8_STAGE(PG8_SB(0, 0), b2, voffB); PG8_STAGE(PG8_SB(0, 1), b2 + hstep, voffB); PG8_STAGE(PG8_SA(0, 0), a2, voffA);
            PG8_WAIT_V(8); PG8_WAIT_L(0); PG8_BAR; PG8_MMA(1, 0, At, B0); PG8_MMA(1, 1, At, B1); PG8_BAR; PG8_SCHED;
            PG8_LDB(B0, 1, 0); PG8_LDB(B1, 1, 1); PG8_SCHED; PG8_LDA(At, 1, 0); PG8_STAGE(PG8_SA(0, 1), a2 + hstep, voffA);
            PG8_WAIT_V(8); PG8_WAIT_L(0); PG8_BAR; PG8_MMA(0, 0, At, B0); PG8_MMA(0, 1, At, B1); PG8_BAR; PG8_SCHED;
            PG8_LDA(At, 1, 1); PG8_STAGE(PG8_SB(1, 0), b3, voffB); PG8_STAGE(PG8_SB(1, 1), b3 + hstep, voffB); PG8_STAGE(PG8_SA(1, 0), a3, voffA);
            PG8_WAIT_V(8); PG8_WAIT_L(0); PG8_BAR; PG8_MMA(1, 0, At, B0); PG8_MMA(1, 1, At, B1); PG8_BAR; PG8_SCHED;
            } else {
            PG8_LDB(B0, 0, 0); PG8_SCHED; PG8_LDA(At, 0, 0); PG8_STAGE(PG8_SA(1, 1), a1 + hstep, voffA);
            PG8_WAIT_L(8); PG8_BAR; PG8_WAIT_L(0); PG8_MMA(0, 0, At, B0); PG8_BAR; PG8_SCHED;
            PG8_LDB(B1, 0, 1); PG8_STAGE(PG8_SB(0, 0), b2, voffB);
            PG8_BAR; PG8_WAIT_L(0); PG8_MMA(0, 1, At, B1); PG8_BAR;
            PG8_LDA(At, 0, 1); PG8_STAGE(PG8_SA(0, 0), a2, voffA);
            PG8_BAR; PG8_WAIT_L(0); PG8_MMA(1, 0, At, B0); PG8_BAR; PG8_SCHED;
            PG8_STAGE(PG8_SB(0, 1), b2 + hstep, voffB);
            PG8_WAIT_V(6); PG8_BAR; PG8_MMA(1, 1, At, B1); PG8_BAR;
            PG8_LDB(B0, 1, 0); PG8_SCHED; PG8_LDA(At, 1, 0); PG8_STAGE(PG8_SA(0, 1), a2 + hstep, voffA);
            PG8_WAIT_L(8); PG8_BAR; PG8_WAIT_L(0); PG8_MMA(0, 0, At, B0); PG8_BAR; PG8_SCHED;
            PG8_LDB(B1, 1, 1); PG8_STAGE(PG8_SB(1, 0), b3, voffB);
            PG8_BAR; PG8_WAIT_L(0); PG8_MMA(0, 1, At, B1); PG8_BAR;
            PG8_LDA(At, 1, 1); PG8_STAGE(PG8_SA(1, 0), a3, voffA);
            PG8_BAR; PG8_WAIT_L(0); PG8_MMA(1, 0, At, B0); PG8_BAR; PG8_SCHED;
            PG8_STAGE(PG8_SB(1, 1), b3 + hstep, voffB);
            PG8_WAIT_V(6); PG8_BAR; PG8_MMA(1, 1, At, B1); PG8_BAR;
            }
        }
        if constexpr (ALIGN_EPI) { if (wr == 0) PG8_BAR; }
        if constexpr (!Epi::AFTER_DRAIN) { E(acc, cur, wr, wc, fr, fq); S.done(cur); }
        if (!has_next) break;
#pragma unroll
        for (int a = 0; a < 2; ++a)
#pragma unroll
            for (int b = 0; b < 2; ++b)
#pragma unroll
                for (int m = 0; m < 4; ++m)
#pragma unroll
                    for (int n = 0; n < 2; ++n) acc[a][b][m][n] = (f32x4){0.f, 0.f, 0.f, 0.f};
        cur = nxt; cA = nA; cB = nB; ++ui;
        if constexpr (ALIGN_EPI) { if (wr == 1) PG8_BAR; }
    }
    PG8_WAIT_V(0);
    if constexpr (!ALIGN_EPI) { if (wr == 0) PG8_BAR; }
    PG8_BAR;
    if constexpr (Epi::AFTER_DRAIN) { E.fused(acc, cur, wr, wc, fr, fq, lds, wid, lane); S.done(cur); }
#undef PG8_SA
#undef PG8_SB
#undef PG8_STAGE
#undef PG8_LDA
#undef PG8_LDB
#undef PG8_MMA
#undef PG8_WAIT_V
#undef PG8_WAIT_L
#undef PG8_BAR
#undef PG8_SCHED
}
}

#ifndef EXP_MIXMASK
#define EXP_MIXMASK 15
#endif
#ifndef EXP_DUPMASK
#define EXP_DUPMASK 15
#endif
#ifndef EXP_DUP
#define EXP_DUP 0
#endif
#ifndef EXP_STOP
#define EXP_STOP 10
#endif
#define LAS __attribute__((address_space(3)))
typedef unsigned short bf16_t;
typedef float f32x4 __attribute__((ext_vector_type(4)));
typedef float f32x2 __attribute__((ext_vector_type(2)));
typedef unsigned u32x4 __attribute__((ext_vector_type(4)));
typedef unsigned u32x2 __attribute__((ext_vector_type(2)));
typedef short bf16x8 __attribute__((ext_vector_type(8)));

constexpr int DM = 1024, NBP = 16, SEQ = 4096, MP = NBP * SEQ, NBS = 8, DSQ = 32, MS = NBS * DSQ, MT = MP + MS;
constexpr int DIN = 2048, DP = 1536, PC_Z = 256, PC_ZS = 512, PC_B = 768, PC_U = 1024, PC_V = 1280, DFF = 2816, NGU = 2 * DFF, WG = 256, PAST = 1024;
constexpr float EPS = 1e-6f;
constexpr size_t MiB = 1u << 20;
constexpr size_t WS_WIN = 0, WS_WOUT = 8 * MiB, WS_WGU = 12 * MiB, WS_WDN = 34 * MiB, WS_WPT = 45 * MiB, WS_WST = 45 * MiB + 65536;
constexpr size_t WS_SSQA = 46 * MiB, WS_SSQB = 51 * MiB, WS_SMALL = 56 * MiB, WS_CTL = 60 * MiB, CTL_BYTES = 16384, WS_HIDS = 61 * MiB;
constexpr int SP_WDW = 0, SP_BDW = SP_WDW + 2 * 31 * 256, SP_LNG = SP_BDW + 512, SP_LNB = SP_LNG + 512, SP_WSC = SP_LNB + 512, SP_BS = SP_WSC + 2 * 3 * 256, SP_GF = SP_BS + 2 * 4 * 128,
              SP_STP = SP_GF + 1024, SP_STC = SP_STP + 2 * 8 * 15 * 256, SP_STS = SP_STC + 2 * 8 * 30 * 256, SP_END = SP_STS + 2 * 8 * 2 * 256;
static_assert(WS_SMALL + (size_t)SP_END * 4 <= WS_CTL && WS_HIDS + (size_t)MS * DFF * 2 <= 64 * MiB, "ws map small");
constexpr size_t WS_XB = 64 * MiB, WS_X = 193 * MiB, WS_P = 450 * MiB, WS_MIX = 707 * MiB, WS_HID = 450 * MiB, WS_PART = 836 * MiB, WS_WDNS = 840 * MiB, WS_END = 852 * MiB;
constexpr int KH = DFF / 2;
static_assert(WS_PART + 2ull * MS * DM * 4 <= WS_WDNS && WS_WDNS + 2ull * 2 * DM * KH * 2 <= WS_END && KH % 128 == 0 && KH % 64 == 0, "split-K buffers");
static_assert(WS_XB + (size_t)MT * DM * 2 <= WS_X && WS_X + (size_t)MT * DM * 4 <= WS_P && WS_P + (size_t)MT * DIN * 2 <= WS_MIX && WS_MIX + (size_t)MT * DM * 2 <= WS_PART && WS_HID + (size_t)MT * DFF * 2 <= WS_PART, "ws map");
static_assert(WS_SSQA + (size_t)MT * 64 <= WS_SSQB && WS_SSQB + (size_t)MT * 64 <= WS_XB, "ws map ssq");
constexpr size_t O_Y = 0, O_POOLP = (size_t)MT * DM, O_POOLS = O_POOLP + 2 * 16 * 15 * 256, O_CONVP = O_POOLS + 2 * 8 * 15 * 256, O_CONVS = O_CONVP + 2 * 16 * 30 * 256,
                 O_SCP = O_CONVS + 2 * 8 * 30 * 256, O_SCS = O_SCP + 2 * 16 * 2 * 256, O_VS = O_SCS + 2 * 8 * 2 * 256, O_END = O_VS + 2 * 8 * 32 * 256;
constexpr int LDS_BYTES = 136192;
constexpr int LDS_RC = 131072 + 512;

__device__ __forceinline__ float bf_lo(unsigned u) { return __uint_as_float(u << 16); }
__device__ __forceinline__ float bf_hi(unsigned u) { return __uint_as_float(u & 0xffff0000u); }
typedef __bf16 bf16x2_t __attribute__((ext_vector_type(2)));
__device__ __forceinline__ unsigned pk_bf16(float lo, float hi) { const f32x2 v = {lo, hi}; const bf16x2_t b = __builtin_convertvector(v, bf16x2_t); return __builtin_bit_cast(unsigned, b); }
__device__ __forceinline__ float wave_sum(float v) {
#pragma unroll
    for (int o = 1; o < 64; o <<= 1) v += __shfl_xor(v, o);
    return v;
}
__device__ __forceinline__ float sigmoidf_(float x) { return 1.0f / (1.0f + __expf(-x)); }

__device__ __forceinline__ float row_rstd(const float* ssq, int row, int fq) {
    const f32x4 s = *(const f32x4*)(ssq + (size_t)row * 16 + 4 * fq);
    float t = (s[0] + s[1]) + (s[2] + s[3]);
    t += __shfl_xor(t, 16); t += __shfl_xor(t, 32);
    return rsqrtf(t * (1.0f / DM) + EPS);
}
__device__ __forceinline__ bool rc_hit(LAS float* rc, const int want, const int wave) { return __builtin_amdgcn_readfirstlane(*(volatile LAS int*)((LAS int*)(rc + 1024) + wave)) == want; }
__device__ __forceinline__ float rc_get(LAS float* rc, const bool hit, const float* ssq, const int row, const int wave, const int slot, const int fr, const int fq) {
    LAS float* e = rc + wave * 128 + slot * 16 + fr;
    if (hit) return *e;
    const float r = row_rstd(ssq, row, fq); if (fq == 0) *e = r; return r;
}
__device__ __forceinline__ void rc_commit(LAS float* rc, const bool hit, const int want, const int wave) { if (!hit) *(volatile LAS int*)((LAS int*)(rc + 1024) + wave) = want; }
struct EpiInProj {
    static constexpr bool PERM = true, AFTER_DRAIN = false;
    bf16_t* P; const float* ssq; LAS float* rc; int salt;
    __device__ __forceinline__ void operator()(const f32x4 (&acc)[2][2][4][2], const pg8::Unit& u, int wr, int wc, int fr, int fq) const {
        asm volatile("" : "+v"(fr));
        const int row0 = u.pm * 256 + wr * 64 + fr, pn = u.pn;
        const int rcw = wr * 4 + wc, rcwant = salt * 1024 + u.pm + 1; const bool rchit = rc_hit(rc, rcwant, rcw);
        const int mode = (pn == 1 || pn == 2) ? 1 : ((pn == 3 || pn == 4) ? 2 : 0);
        const int dcol = (pn == 0) ? 0 : (mode == 1 ? PC_Z + 128 * (pn - 1) : (mode == 2 ? PC_ZS + 128 * (pn - 3) : PC_B + 256 * (pn - 5)));
        const int col0 = dcol + wc * 32 + 8 * fq;
#pragma unroll
        for (int ai = 0; ai < 2; ++ai)
#pragma unroll
            for (int m = 0; m < 4; ++m) {
                const int row = row0 + ai * 128 + m * 16; const float rs = rc_get(rc, rchit, ssq, row, rcw, ai * 4 + m, fr, fq);
                bf16_t* rowp = P + (size_t)row * DP + col0;
                if (mode == 0) {
#pragma unroll
                    for (int bj = 0; bj < 2; ++bj) { const f32x4 v0 = acc[ai][bj][m][0] * rs, v1 = acc[ai][bj][m][1] * rs;
                        u32x4 w; w.x = pk_bf16(v0[0], v0[1]); w.y = pk_bf16(v0[2], v0[3]); w.z = pk_bf16(v1[0], v1[1]); w.w = pk_bf16(v1[2], v1[3]);
                        __builtin_nontemporal_store(w, (u32x4*)(rowp + bj * 128)); }
                } else {
                    float h[8];
                    const float c1 = rs * -1.4426950408889634f, rs2 = rs * rs;
#pragma unroll
                    for (int n = 0; n < 2; ++n)
#pragma unroll
                        for (int j = 0; j < 4; j += 2) { const f32x2 a = {acc[ai][0][m][n][j], acc[ai][0][m][n][j + 1]}, b = {acc[ai][1][m][n][j], acc[ai][1][m][n][j + 1]};
                            f32x2 hh;
                            if (mode == 1) { const f32x2 t = b * c1; f32x2 e; e.x = __builtin_amdgcn_exp2f(t.x); e.y = __builtin_amdgcn_exp2f(t.y);
                                const f32x2 d = e + 1.0f; f32x2 r; r.x = __builtin_amdgcn_rcpf(d.x); r.y = __builtin_amdgcn_rcpf(d.y); hh = (a * rs) * r; }
                            else hh = (a * b) * rs2;
                            h[n * 4 + j] = hh.x; h[n * 4 + j + 1] = hh.y; }
                    u32x4 w; w.x = pk_bf16(h[0], h[1]); w.y = pk_bf16(h[2], h[3]); w.z = pk_bf16(h[4], h[5]); w.w = pk_bf16(h[6], h[7]);
                    __builtin_nontemporal_store(w, (u32x4*)rowp);
                }
            }
        rc_commit(rc, rchit, rcwant, rcw);
    }
};
struct EpiSwiGLU {
    static constexpr bool PERM = true, AFTER_DRAIN = false;
    bf16_t* H; const float* ssq; LAS float* rc; int salt;
    __device__ __forceinline__ void operator()(const f32x4 (&acc)[2][2][4][2], const pg8::Unit& u, int wr, int wc, int fr, int fq) const {
        asm volatile("" : "+v"(fr));
        const int row0 = u.pm * 256 + wr * 64 + fr, col0 = u.pn * 128 + wc * 32 + 8 * fq;
        const int rcw = wr * 4 + wc, rcwant = salt * 1024 + u.pm + 1; const bool rchit = rc_hit(rc, rcwant, rcw);
#pragma unroll
        for (int ai = 0; ai < 2; ++ai)
#pragma unroll
            for (int m = 0; m < 4; ++m) {
                const int row = row0 + ai * 128 + m * 16; const float rs = rc_get(rc, rchit, ssq, row, rcw, ai * 4 + m, fr, fq);
                float h[8];
                const float c1 = rs * -1.4426950408889634f, rs2 = rs * rs;
#pragma unroll
                for (int n = 0; n < 2; ++n)
#pragma unroll
                    for (int j = 0; j < 4; j += 2) { const f32x2 ag = {acc[ai][0][m][n][j], acc[ai][0][m][n][j + 1]}, au = {acc[ai][1][m][n][j], acc[ai][1][m][n][j + 1]};
                        const f32x2 t = ag * c1; f32x2 e; e.x = __builtin_amdgcn_exp2f(t.x); e.y = __builtin_amdgcn_exp2f(t.y);
                        const f32x2 d = e + 1.0f; f32x2 r; r.x = __builtin_amdgcn_rcpf(d.x); r.y = __builtin_amdgcn_rcpf(d.y);
                        const f32x2 hh = (ag * au) * (r * rs2); h[n * 4 + j] = hh.x; h[n * 4 + j + 1] = hh.y; }
                u32x4 w; w.x = pk_bf16(h[0], h[1]); w.y = pk_bf16(h[2], h[3]); w.z = pk_bf16(h[4], h[5]); w.w = pk_bf16(h[6], h[7]);
                __builtin_nontemporal_store(w, (u32x4*)(H + (size_t)row * DFF + col0));
            }
        rc_commit(rc, rchit, rcwant, rcw);
    }
};
struct EpiResid {
    static constexpr bool PERM = false, AFTER_DRAIN = false;
    const float* rp; bf16_t* XB; float* ssq;
    __device__ __forceinline__ void operator()(const f32x4 (&acc)[2][2][4][2], const pg8::Unit& u, int wr, int wc, int fr, int fq) const {
        asm volatile("" : "+v"(fr));
        const int row0 = u.pm * 256 + wr * 64 + fr, col0 = u.pn * 256 + wc * 32 + 4 * fq;
        const bool rf32 = (rp != nullptr) && (u.pm < MP / 256);
#pragma unroll
        for (int ai = 0; ai < 2; ++ai)
#pragma unroll
            for (int m = 0; m < 4; ++m) {
                const int row = row0 + ai * 128 + m * 16; const size_t off = (size_t)row * DM + col0; float q = 0.f;
                f32x4 r4[2][2];
                if (rf32) {
#pragma unroll
                    for (int bj = 0; bj < 2; ++bj)
#pragma unroll
                        for (int n = 0; n < 2; ++n) r4[bj][n] = *(const f32x4*)(rp + off + bj * 128 + n * 16);
                } else {
#pragma unroll
                    for (int bj = 0; bj < 2; ++bj)
#pragma unroll
                        for (int n = 0; n < 2; ++n) { const u32x2 w = *(const u32x2*)(XB + off + bj * 128 + n * 16); r4[bj][n] = (f32x4){bf_lo(w.x), bf_hi(w.x), bf_lo(w.y), bf_hi(w.y)}; }
                }
#pragma unroll
                for (int bj = 0; bj < 2; ++bj)
#pragma unroll
                    for (int n = 0; n < 2; ++n) { const f32x4 x4 = r4[bj][n] + acc[ai][bj][m][n];
                        q += (x4[0] * x4[0] + x4[1] * x4[1]) + (x4[2] * x4[2] + x4[3] * x4[3]);
                        u32x2 w; w.x = pk_bf16(x4[0], x4[1]); w.y = pk_bf16(x4[2], x4[3]); *(u32x2*)(XB + off + bj * 128 + n * 16) = w; }
                q += __shfl_xor(q, 16); q += __shfl_xor(q, 32);
                if (fq == 0) ssq[(size_t)row * 16 + u.pn * 4 + wc] = q;
                if (m & 1) asm volatile("" ::: "memory");
            }
    }
};

struct Params {
    const float* x_prompt; const float* x_sample; const float* st_pool; const float* st_conv; const float* st_sc; const float* g_mix; const float* w_in; const float* w_pool;
    const float* pool_scale; const float* w_dw; const float* b_dw; const float* ln_g; const float* ln_b; const float* w_sconv; const float* w_s; const float* b_s; const float* w_out;
    const float* g_ffn; const float* w_gate; const float* w_up; const float* w_down; const float* g_final;
    float* out; unsigned char* ws;
};

__device__ __forceinline__ void transpose_item(const float* W, const float* gk, int K, int N, bf16_t* WT, int dst_row0, LAS float* scr, int k0, int n0, int lane, bf16_t* WT2 = nullptr, int K2 = 0, int k02 = 0) {
    float tv[32];
#pragma unroll
    for (int i = 0; i < 32; ++i) { const int kk = 2 * i + (lane >> 5); tv[i] = W[(size_t)(k0 + kk) * N + n0 + (lane & 31)]; }
#pragma unroll
    for (int i = 0; i < 32; ++i) { const int kk = 2 * i + (lane >> 5); float v = tv[i]; if (gk) v *= gk[k0 + kk]; scr[kk * 33 + (lane & 31)] = v; }
    asm volatile("s_waitcnt lgkmcnt(0)" ::: "memory");
    const int c = lane & 7;
#pragma unroll
    for (int j = 0; j < 4; ++j) { const int n = (lane >> 3) + 8 * j; const LAS float* s = scr + (8 * c) * 33 + n;
        u32x4 o; o.x = pk_bf16(s[0 * 33], s[1 * 33]); o.y = pk_bf16(s[2 * 33], s[3 * 33]); o.z = pk_bf16(s[4 * 33], s[5 * 33]); o.w = pk_bf16(s[6 * 33], s[7 * 33]);
        *(u32x4*)(WT + (size_t)(dst_row0 + n) * K + k0 + 8 * c) = o;
        if (WT2) *(u32x4*)(WT2 + (size_t)(dst_row0 + n) * K2 + k02 + 8 * c) = o; }
    asm volatile("s_waitcnt lgkmcnt(0)" ::: "memory");
}
__device__ __forceinline__ void prologue(const Params& p, LAS unsigned char* lds, int tid, int lane, int wave) {
    LAS float* scr = (LAS float*)(lds + wave * 16384);
    const int gw = blockIdx.x * 8 + wave, NGW = gridDim.x * 8;
    constexpr int I_IN = (DM / 64) * (DIN / 32), I_OUT = (DM / 64) * (DM / 32), I_G = (DM / 64) * (DFF / 32), I_DN = (DFF / 64) * (DM / 32);
    constexpr int I_LAYER = I_IN + I_OUT + 2 * I_G + I_DN;
    bf16_t* WIN = (bf16_t*)(p.ws + WS_WIN); bf16_t* WOUT = (bf16_t*)(p.ws + WS_WOUT); bf16_t* WGU = (bf16_t*)(p.ws + WS_WGU); bf16_t* WDN = (bf16_t*)(p.ws + WS_WDN);
    for (int it = gw; it < 2 * I_LAYER; it += NGW) {
        const int l = it / I_LAYER; int r = it % I_LAYER;
        if (r < I_IN) { const int nb = DIN / 32, k0 = 64 * (r / nb), n0 = 32 * (r % nb); const int seg = n0 >> 8, off = n0 & 255, hi = off >> 7, lo = off & 127;
            const int drow = (seg == 0) ? off : (seg == 1) ? 256 * (1 + hi) + lo : (seg == 2) ? 256 * (1 + hi) + 128 + lo : (seg == 3) ? 256 * (3 + hi) + lo : (seg == 5) ? 256 * (3 + hi) + 128 + lo : (seg == 4) ? 256 * 5 + off : 256 * seg + off;
            transpose_item(p.w_in + (size_t)l * DM * DIN, p.g_mix + l * DM, DM, DIN, WIN + (size_t)l * DIN * DM, drow, scr, k0, n0, lane); continue; } r -= I_IN;
        if (r < I_OUT) { const int nb = DM / 32, k0 = 64 * (r / nb), n0 = 32 * (r % nb); transpose_item(p.w_out + (size_t)l * DM * DM, nullptr, DM, DM, WOUT + (size_t)l * DM * DM, n0, scr, k0, n0, lane); continue; } r -= I_OUT;
        if (r < I_G) { const int nb = DFF / 32, k0 = 64 * (r / nb), n0 = 32 * (r % nb); transpose_item(p.w_gate + (size_t)l * DM * DFF, p.g_ffn + l * DM, DM, DFF, WGU + (size_t)l * NGU * DM, (n0 >> 7) * 256 + (n0 & 127), scr, k0, n0, lane); continue; } r -= I_G;
        if (r < I_G) { const int nb = DFF / 32, k0 = 64 * (r / nb), n0 = 32 * (r % nb); transpose_item(p.w_up + (size_t)l * DM * DFF, p.g_ffn + l * DM, DM, DFF, WGU + (size_t)l * NGU * DM, (n0 >> 7) * 256 + 128 + (n0 & 127), scr, k0, n0, lane); continue; } r -= I_G;
        { const int nb = DM / 32, k0 = 64 * (r / nb), n0 = 32 * (r % nb); const int kh = k0 / KH; transpose_item(p.w_down + (size_t)l * DFF * DM, nullptr, DFF, DM, WDN + (size_t)l * DM * DFF, n0, scr, k0, n0, lane, (bf16_t*)(p.ws + WS_WDNS) + (size_t)(l * 2 + kh) * DM * KH, KH, k0 - kh * KH); }
    }
    {
        bf16_t* WPT = (bf16_t*)(p.ws + WS_WPT); bf16_t* WST = (bf16_t*)(p.ws + WS_WST);
        const int gt = blockIdx.x * 512 + tid, NGT = gridDim.x * 512;
        for (int e = gt; e < 2 * 4 * 64 * 64; e += NGT) { const int c = e & 63, d = (e >> 6) & 63, lg = e >> 12;
            const float v = p.w_pool[((size_t)lg * 64 + c) * 64 + d] * p.pool_scale[(lg >> 2) * 256 + (lg & 3) * 64 + d]; WPT[e] = (bf16_t)(pk_bf16(v, 0.f) & 0xffffu); }
        for (int e = gt; e < 2 * 4 * 128 * 128; e += NGT) { const int j = e & 127, i = (e >> 7) & 127; const float v = (j <= i) ? p.w_s[e] : 0.f; WST[e] = (bf16_t)(pk_bf16(v, 0.f) & 0xffffu); }
    }
    {
        float* SP = (float*)(p.ws + WS_SMALL);
        const int gt = blockIdx.x * 512 + tid, NGT = gridDim.x * 512;
        for (int e = gt; e < SP_END; e += NGT) {
            float v;
            if (e < SP_BDW) v = p.w_dw[e - SP_WDW]; else if (e < SP_LNG) v = p.b_dw[e - SP_BDW]; else if (e < SP_LNB) v = p.ln_g[e - SP_LNG]; else if (e < SP_WSC) v = p.ln_b[e - SP_LNB];
            else if (e < SP_BS) v = p.w_sconv[e - SP_WSC]; else if (e < SP_GF) v = p.b_s[e - SP_BS]; else if (e < SP_STP) v = p.g_final[e - SP_GF]; else if (e < SP_STC) v = p.st_pool[e - SP_STP];
            else if (e < SP_STS) v = p.st_conv[e - SP_STC]; else v = p.st_sc[e - SP_STS];
            SP[e] = v;
        }
    }
}

__device__ __forceinline__ void convert_rows(const Params& p, int lane, const int gw, const int NGW, const int row_lo, const int row_hi) {
    bf16_t* XB = (bf16_t*)(p.ws + WS_XB); float* SSQ = (float*)(p.ws + WS_SSQA);
    for (int m0 = row_lo + gw; m0 < row_hi; m0 += 4 * NGW) {
        f32x4 v[4][4]; float s[4];
#pragma unroll
        for (int h = 0; h < 4; ++h) { const int m = m0 + h * NGW; const int mm = m < row_hi ? m : m0;
            const float* xrow = (mm < MP) ? p.x_prompt + (size_t)mm * DM : p.x_sample + (size_t)(mm - MP) * DM; const f32x4* xr = (const f32x4*)xrow + lane;
#pragma unroll
            for (int j = 0; j < 4; ++j) v[h][j] = xr[64 * j]; }
#pragma unroll
        for (int h = 0; h < 4; ++h) { const int m = m0 + h * NGW;
            float q = 0.f;
#pragma unroll
            for (int j = 0; j < 4; ++j) q += (v[h][j][0] * v[h][j][0] + v[h][j][1] * v[h][j][1]) + (v[h][j][2] * v[h][j][2] + v[h][j][3] * v[h][j][3]);
            s[h] = wave_sum(q);
            if (m < row_hi) { u32x2* o8 = (u32x2*)(XB + (size_t)m * DM) + lane;
#pragma unroll
                for (int j = 0; j < 4; ++j) { u32x2 w; w.x = pk_bf16(v[h][j][0], v[h][j][1]); w.y = pk_bf16(v[h][j][2], v[h][j][3]); o8[64 * j] = w; }
                if (lane < 16) SSQ[(size_t)m * 16 + lane] = (lane == 0) ? s[h] : 0.f; } }
    }
}

struct Tile { int g0, R, t0, sb, b, last; };
__device__ __forceinline__ Tile prompt_tile(int q, int R) { Tile t; t.g0 = q * R; t.R = R; t.t0 = t.g0 & (SEQ - 1); t.sb = -1; t.b = t.g0 / SEQ; t.last = (t.t0 + R == SEQ); return t; }
__device__ __forceinline__ Tile sample_tile(int b) { Tile t; t.g0 = MP + b * DSQ; t.R = DSQ; t.t0 = PAST; t.sb = b; t.b = b; t.last = 1; return t; }
__device__ __forceinline__ void unpack8(const u32x4 w, float* f) { f[0] = bf_lo(w.x); f[1] = bf_hi(w.x); f[2] = bf_lo(w.y); f[3] = bf_hi(w.y); f[4] = bf_lo(w.z); f[5] = bf_hi(w.z); f[6] = bf_lo(w.w); f[7] = bf_hi(w.w); }
__device__ __forceinline__ void store8f(float* dst, const float* f) { *(f32x4*)dst = (f32x4){f[0], f[1], f[2], f[3]}; *(f32x4*)(dst + 4) = (f32x4){f[4], f[5], f[6], f[7]}; }
__device__ __forceinline__ void load8f(const float* src, float* f) { const f32x4 a = *(const f32x4*)src, b = *(const f32x4*)(src + 4); f[0] = a[0]; f[1] = a[1]; f[2] = a[2]; f[3] = a[3]; f[4] = b[0]; f[5] = b[1]; f[6] = b[2]; f[7] = b[3]; }
#define WG_BAR() do { asm volatile("s_waitcnt lgkmcnt(0)" ::: "memory"); __builtin_amdgcn_s_barrier(); asm volatile("" ::: "memory"); } while (0)

template <int H, int K>
__device__ __forceinline__ void xstep(float (&v)[16], int lane) {
    const bool up = (lane >> K) & 1;
#pragma unroll
    for (int i = 0; i < H; ++i) { const float send = up ? v[i] : v[i + H]; const float keep = up ? v[i + H] : v[i]; v[i] = keep + __shfl_xor(send, 1 << K); }
}
__device__ __forceinline__ float xreduce16(float (&v)[16], int lane) {
    xstep<8, 0>(v, lane); xstep<4, 1>(v, lane); xstep<2, 2>(v, lane); xstep<1, 3>(v, lane);
    float r = v[0]; r += __shfl_xor(r, 16); r += __shfl_xor(r, 32); return r;
}
__device__ __forceinline__ void conv_block(const LAS float* z, LAS float* st, const float (&w)[31], float bias, int r0, int c, int lane, int wq, float (&cv)[8]) {
    float win[38];
#pragma unroll
    for (int i = 0; i < 38; ++i) win[i] = z[(r0 + i) * 256 + c];
    float sv[16];
#pragma unroll
    for (int j = 0; j < 8; ++j) { float a = bias;
#pragma unroll
        for (int k = 0; k < 31; ++k) a += w[k] * win[j + k];
        asm volatile("" : "+v"(a));
        cv[j] = a; sv[2 * j] = a; sv[2 * j + 1] = a * a; }
    const float r = xreduce16(sv, lane);
    const int idx = ((lane & 1) << 3) | ((lane & 2) << 1) | ((lane & 4) >> 1) | ((lane & 8) >> 3);
    if (lane < 16) st[((r0 + (idx >> 1)) * 4 + wq) * 2 + (idx & 1)] = r;
}
__device__ __forceinline__ void conv_norm(const LAS float* st, const float (&cv)[8], int r0, float lg, float lb, bf16_t* mixrow) {
#pragma unroll
    for (int j = 0; j < 8; ++j) { const LAS float* sp = st + (r0 + j) * 8;
        const float s = (sp[0] + sp[2]) + (sp[4] + sp[6]), q = (sp[1] + sp[3]) + (sp[5] + sp[7]);
        const float mean = s * (1.0f / 256.0f); float var = q * (1.0f / 256.0f) - mean * mean; var = var < 0.f ? 0.f : var;
        const float n = (cv[j] - mean) * rsqrtf(var + EPS) * lg + lb;
        const float y = n * __builtin_amdgcn_rcpf(1.0f + __builtin_amdgcn_exp2f(n * -1.4426950408889634f));
        mixrow[(size_t)j * DM] = (bf16_t)(pk_bf16(y, 0.f) & 0xffffu); }
}
__device__ __forceinline__ void mix_conv(const Params& p, int l, const Tile t, const bf16_t* P, bf16_t* MIX, LAS unsigned char* lds, int tid) {
    LAS float* z = (LAS float*)lds;
    LAS float* st = (LAS float*)(lds + 94 * 256 * 4);
    const float* SP = (const float*)(p.ws + WS_SMALL);
    const int lane = tid & 63, wave = tid >> 6;
    const int nitems = (t.R + 30) * 32;
    const bool hist_from_p = (t.sb < 0) && (t.t0 != 0);
    float* oconv = p.out + ((t.sb < 0) ? O_CONVP + (size_t)(l * NBP + t.b) * 30 * 256 : O_CONVS + (size_t)(l * NBS + t.b) * 30 * 256);
    {
        u32x4 A[6], G[6];
#pragma unroll
        for (int i = 0; i < 6; ++i) { const int idx = tid + 512 * i, rr = idx >> 5, c8 = (idx & 31) * 8, rrel = rr - 30;
            A[i] = (u32x4){0u, 0u, 0u, 0u}; G[i] = (u32x4){0u, 0u, 0u, 0u};
            if (idx < nitems) {
                if (rrel >= 0 || hist_from_p) A[i] = *(const u32x4*)(P + (size_t)(t.g0 + rrel) * DP + PC_Z + c8);
                else if (t.sb >= 0) { const float* sp = SP + SP_STC + ((size_t)(l * NBS + t.b) * 30 + rr) * 256 + c8; A[i] = *(const u32x4*)sp; G[i] = *(const u32x4*)(sp + 4); } } }
#pragma unroll
        for (int i = 0; i < 6; ++i) { const int idx = tid + 512 * i, rr = idx >> 5, c8 = (idx & 31) * 8, rrel = rr - 30;
            if (idx < nitems) { float zz[8];
                if (rrel >= 0 || hist_from_p) unpack8(A[i], zz);
                else { zz[0] = __uint_as_float(A[i].x); zz[1] = __uint_as_float(A[i].y); zz[2] = __uint_as_float(A[i].z); zz[3] = __uint_as_float(A[i].w);
                       zz[4] = __uint_as_float(G[i].x); zz[5] = __uint_as_float(G[i].y); zz[6] = __uint_as_float(G[i].z); zz[7] = __uint_as_float(G[i].w); }
                *(LAS f32x4*)(z + rr * 256 + c8) = (f32x4){zz[0], zz[1], zz[2], zz[3]}; *(LAS f32x4*)(z + rr * 256 + c8 + 4) = (f32x4){zz[4], zz[5], zz[6], zz[7]};
                if (t.last && rrel >= t.R - 30) store8f(oconv + (size_t)(rrel - (t.R - 30)) * 256 + c8, zz); } }
    }
    const int c = tid & 255, half = tid >> 8, rph = t.R >> 1, nblk = rph >> 3;
    float w[31];
#pragma unroll
    for (int k = 0; k < 31; ++k) w[k] = SP[SP_WDW + (l * 31 + k) * 256 + c];
    const float bias = SP[SP_BDW + l * 256 + c];
    const float lg = SP[SP_LNG + l * 256 + c], lb = SP[SP_LNB + l * 256 + c];
    WG_BAR();
    float cv[4][8];
#pragma unroll
    for (int blk = 0; blk < 4; ++blk) if (blk < nblk) conv_block(z, st, w, bias, half * rph + blk * 8, c, lane, wave & 3, cv[blk]);
    WG_BAR();
#pragma unroll
    for (int blk = 0; blk < 4; ++blk) if (blk < nblk) { const int r0 = half * rph + blk * 8; conv_norm(st, cv[blk], r0, lg, lb, MIX + (size_t)(t.g0 + r0) * DM + 256 + c); }
    WG_BAR();
}

__device__ __forceinline__ void mix_pool(const Params& p, int l, const Tile t, const bf16_t* P, bf16_t* MIX, LAS unsigned char* lds, int tid) {
    LAS float* xs = (LAS float*)lds;
    LAS bf16_t* pre = (LAS bf16_t*)(lds + 79 * 256 * 4);
    const float* SP = (const float*)(p.ws + WS_SMALL);
    const int lane = tid & 63, wave = tid >> 6;
    const int nitems = (t.R + 15) * 32;
    const bool hist_from_p = (t.sb < 0) && (t.t0 != 0);
    float* opool = p.out + ((t.sb < 0) ? O_POOLP + (size_t)(l * NBP + t.b) * 15 * 256 : O_POOLS + (size_t)(l * NBS + t.b) * 15 * 256);
    {
        u32x4 A[5], B[5];
#pragma unroll
        for (int i = 0; i < 5; ++i) { const int idx = tid + 512 * i, rr = idx >> 5, c8 = (idx & 31) * 8, rrel = rr - 15;
            A[i] = (u32x4){0u, 0u, 0u, 0u}; B[i] = (u32x4){0u, 0u, 0u, 0u};
            if (idx < nitems) {
                if (rrel >= 0 || hist_from_p) A[i] = *(const u32x4*)(P + (size_t)(t.g0 + rrel) * DP + c8);
                else if (t.sb >= 0) { const float* sp = SP + SP_STP + ((size_t)(l * NBS + t.b) * 15 + rr) * 256 + c8; A[i] = *(const u32x4*)sp; B[i] = *(const u32x4*)(sp + 4); } } }
#pragma unroll
        for (int i = 0; i < 5; ++i) { const int idx = tid + 512 * i, rr = idx >> 5, c8 = (idx & 31) * 8, rrel = rr - 15;
            if (idx < nitems) { float v[8];
                if (rrel >= 0 || hist_from_p) unpack8(A[i], v);
                else { v[0] = __uint_as_float(A[i].x); v[1] = __uint_as_float(A[i].y); v[2] = __uint_as_float(A[i].z); v[3] = __uint_as_float(A[i].w);
                       v[4] = __uint_as_float(B[i].x); v[5] = __uint_as_float(B[i].y); v[6] = __uint_as_float(B[i].z); v[7] = __uint_as_float(B[i].w); }
                *(LAS f32x4*)(xs + rr * 256 + c8) = (f32x4){v[0], v[1], v[2], v[3]}; *(LAS f32x4*)(xs + rr * 256 + c8 + 4) = (f32x4){v[4], v[5], v[6], v[7]};
                if (t.last && rrel >= t.R - 15) store8f(opool + (size_t)(rrel - (t.R - 15)) * 256 + c8, v); } }
    }
    const int g = wave >> 1, rh = wave & 1, fr = lane & 15, fq = lane >> 4, rph = t.R >> 1, mt = t.R >> 5;
    bf16x8 bf[4][2];
    {
        const bf16_t* WPT = (const bf16_t*)(p.ws + WS_WPT) + (size_t)(l * 4 + g) * 64 * 64;
#pragma unroll
        for (int n = 0; n < 4; ++n)
#pragma unroll
            for (int k = 0; k < 2; ++k) bf[n][k] = *(const bf16x8*)(WPT + (16 * n + fr) * 64 + 32 * k + 8 * fq);
    }
    WG_BAR();
    {
        const int c = tid & 255, half = tid >> 8, gg = c >> 6, w = 2 << gg;
        float mk[16];
#pragma unroll
        for (int j = 0; j < 16; ++j) mk[j] = (j < w) ? 1.0f : 0.0f;
        for (int r0 = half * rph; r0 < (half + 1) * rph; r0 += 4) {
            float v[19];
#pragma unroll
            for (int i = 0; i < 19; ++i) v[i] = xs[(r0 + i) * 256 + c];
#pragma unroll
            for (int q = 0; q < 4; ++q) { float s = 0.f;
#pragma unroll
                for (int j = 0; j < 16; ++j) s += mk[j] * v[q + 15 - j];
                const int pos = t.t0 + r0 + q; const float cnt = (float)((pos + 1 < w) ? pos + 1 : w);
                const float pv = s * __builtin_amdgcn_rcpf(cnt) - v[q + 15];
                pre[(r0 + q) * 264 + c] = (bf16_t)(pk_bf16(pv, 0.f) & 0xffffu); }
        }
    }
    WG_BAR();
#pragma unroll
    for (int m = 0; m < 2; ++m) {
        if (m < mt) {
            const int row = rh * rph + 16 * m + fr;
            bf16x8 af[2];
#pragma unroll
            for (int k = 0; k < 2; ++k) af[k] = *(const LAS bf16x8*)(pre + row * 264 + g * 64 + 32 * k + 8 * fq);
#pragma unroll
            for (int n = 0; n < 4; ++n) { f32x4 a = {0.f, 0.f, 0.f, 0.f};
#pragma unroll
                for (int k = 0; k < 2; ++k) a = __builtin_amdgcn_mfma_f32_16x16x32_bf16(bf[n][k], af[k], a, 0, 0, 0);
                u32x2 o; o.x = pk_bf16(a[0], a[1]); o.y = pk_bf16(a[2], a[3]);
                *(u32x2*)(MIX + (size_t)(t.g0 + row) * DM + g * 64 + 16 * n + 4 * fq) = o; }
        }
    }
    WG_BAR();
}

__device__ __forceinline__ void mix_sconv(const Params& p, int l, const Tile t, const bf16_t* P, bf16_t* MIX, int tid) {
    const bool hist_from_p = (t.sb < 0) && (t.t0 != 0);
    const float* SP = (const float*)(p.ws + WS_SMALL);
    float* osc = p.out + ((t.sb < 0) ? O_SCP + (size_t)(l * NBP + t.b) * 2 * 256 : O_SCS + (size_t)(l * NBS + t.b) * 2 * 256);
    const int c8 = (tid & 31) * 8, r0 = (tid >> 5) * 4;
    if (r0 >= t.R) return;
    u32x4 XS[6], CG[6], BG[4];
#pragma unroll
    for (int i = 0; i < 6; ++i) { const int rrel = r0 - 2 + i; XS[i] = (u32x4){0u, 0u, 0u, 0u}; CG[i] = (u32x4){0u, 0u, 0u, 0u};
        if (rrel >= 0 || hist_from_p) XS[i] = *(const u32x4*)(P + (size_t)(t.g0 + rrel) * DP + PC_ZS + c8);
        else if (t.sb >= 0) { const float* sp = SP + SP_STS + ((size_t)(l * NBS + t.b) * 2 + (rrel + 2)) * 256 + c8; XS[i] = *(const u32x4*)sp; CG[i] = *(const u32x4*)(sp + 4); } }
#pragma unroll
    for (int i = 0; i < 4; ++i) BG[i] = *(const u32x4*)(P + (size_t)(t.g0 + r0 + i) * DP + PC_B + c8);
    float w0[8], w1[8], w2[8];
    load8f(SP + SP_WSC + (l * 3 + 0) * 256 + c8, w0); load8f(SP + SP_WSC + (l * 3 + 1) * 256 + c8, w1); load8f(SP + SP_WSC + (l * 3 + 2) * 256 + c8, w2);
    float z[6][8];
#pragma unroll
    for (int i = 0; i < 6; ++i) { const int rrel = r0 - 2 + i;
        if (rrel >= 0 || hist_from_p) unpack8(XS[i], z[i]);
        else { z[i][0] = __uint_as_float(XS[i].x); z[i][1] = __uint_as_float(XS[i].y); z[i][2] = __uint_as_float(XS[i].z); z[i][3] = __uint_as_float(XS[i].w);
               z[i][4] = __uint_as_float(CG[i].x); z[i][5] = __uint_as_float(CG[i].y); z[i][6] = __uint_as_float(CG[i].z); z[i][7] = __uint_as_float(CG[i].w); } }
#pragma unroll
    for (int i = 0; i < 4; ++i) { const int r = r0 + i; float bg[8], o[8]; unpack8(BG[i], bg);
#pragma unroll
        for (int e = 0; e < 8; ++e) o[e] = bg[e] * (w0[e] * z[i][e] + w1[e] * z[i + 1][e] + w2[e] * z[i + 2][e]);
        u32x4 w; w.x = pk_bf16(o[0], o[1]); w.y = pk_bf16(o[2], o[3]); w.z = pk_bf16(o[4], o[5]); w.w = pk_bf16(o[6], o[7]);
        *(u32x4*)(MIX + (size_t)(t.g0 + r) * DM + 512 + c8) = w;
        if (t.last && r >= t.R - 2) store8f(osc + (size_t)(r - (t.R - 2)) * 256 + c8, z[i + 2]); }
}

template <int R>
__device__ __forceinline__ void mix_mlp(const Params& p, int l, const Tile t, const bf16_t* P, bf16_t* MIX, LAS unsigned char* lds, int tid) {
    LAS unsigned* vs32 = (LAS unsigned*)lds;
    const LAS bf16_t* vs = (const LAS bf16_t*)lds;
    const int lane = tid & 63, wave = tid >> 6;
    constexpr int NIT = R * 32 / 512;
    {
        u32x4 V[NIT];
#pragma unroll
        for (int i = 0; i < NIT; ++i) { const int idx = tid + 512 * i, r = idx >> 5, c8 = (idx & 31) * 8; V[i] = *(const u32x4*)(P + (size_t)(t.g0 + r) * DP + PC_V + c8); }
#pragma unroll
        for (int i = 0; i < NIT; ++i) { const int idx = tid + 512 * i, r = idx >> 5, c8 = (idx & 31) * 8;
            LAS unsigned* d = vs32 + r * 129 + (c8 >> 1); d[0] = V[i].x; d[1] = V[i].y; d[2] = V[i].z; d[3] = V[i].w;
            if (R == 32) { float f[8]; unpack8(V[i], f); store8f(p.out + O_VS + ((size_t)(l * NBS + t.b) * 32 + r) * 256 + c8, f); } }
    }
    const int h = wave >> 1, rh = wave & 1, fr = lane & 15, fq = lane >> 4;
    constexpr int MMAX = (R == 128) ? 4 : 2, KMAX = (R == 128) ? 4 : 1;
    const int kmax = (R == 128) ? 2 * (rh + 1) : 1;
    const bool active = (R == 128 || rh == 0);
    bf16x8 af[KMAX][MMAX]; u32x2 uu[MMAX][4]; float bias[MMAX];
    if (active) {
        const bf16_t* WST = (const bf16_t*)(p.ws + WS_WST) + (size_t)(l * 4 + h) * 128 * 128;
#pragma unroll
        for (int k = 0; k < KMAX; ++k)
#pragma unroll
            for (int m = 0; m < MMAX; ++m) af[k][m] = (k < kmax) ? *(const bf16x8*)(WST + (size_t)(64 * rh + 16 * m + fr) * 128 + 32 * k + 8 * fq) : (bf16x8){0, 0, 0, 0, 0, 0, 0, 0};
#pragma unroll
        for (int m = 0; m < MMAX; ++m) { const int i = 64 * rh + 16 * m + fr; bias[m] = ((const float*)(p.ws + WS_SMALL))[SP_BS + (l * 4 + h) * 128 + i];
#pragma unroll
            for (int n = 0; n < 4; ++n) uu[m][n] = *(const u32x2*)(P + (size_t)(t.g0 + i) * DP + PC_U + 64 * h + 16 * n + 4 * fq); }
    }
    WG_BAR();
    if (active) {
        f32x4 acc[MMAX][4];
#pragma unroll
        for (int m = 0; m < MMAX; ++m)
#pragma unroll
            for (int n = 0; n < 4; ++n) acc[m][n] = (f32x4){0.f, 0.f, 0.f, 0.f};
#pragma unroll
        for (int k = 0; k < KMAX; ++k) {
            if (k < kmax) {
                bf16x8 bf[4];
#pragma unroll
                for (int n = 0; n < 4; ++n)
#pragma unroll
                    for (int i = 0; i < 8; ++i) bf[n][i] = (short)vs[(32 * k + 8 * fq + i) * 258 + 64 * h + 16 * n + fr];
#pragma unroll
                for (int m = 0; m < MMAX; ++m)
#pragma unroll
                    for (int n = 0; n < 4; ++n) acc[m][n] = __builtin_amdgcn_mfma_f32_16x16x32_bf16(bf[n], af[k][m], acc[m][n], 0, 0, 0);
            }
        }
#pragma unroll
        for (int m = 0; m < MMAX; ++m) {
            const int i = 64 * rh + 16 * m + fr;
#pragma unroll
            for (int n = 0; n < 4; ++n) { const int d = 64 * h + 16 * n + 4 * fq;
                const float o0 = bf_lo(uu[m][n].x) * (acc[m][n][0] + bias[m]), o1 = bf_hi(uu[m][n].x) * (acc[m][n][1] + bias[m]), o2 = bf_lo(uu[m][n].y) * (acc[m][n][2] + bias[m]), o3 = bf_hi(uu[m][n].y) * (acc[m][n][3] + bias[m]);
                u32x2 o; o.x = pk_bf16(o0, o1); o.y = pk_bf16(o2, o3);
                *(u32x2*)(MIX + (size_t)(t.g0 + i) * DM + 768 + d) = o; }
        }
    }
    WG_BAR();
}


__device__ __forceinline__ void conv_loads(const Tile t, const bf16_t* P, int tid, u32x4 (&A)[6]) {
    const bool hist = (t.t0 != 0);
#pragma unroll
    for (int i = 0; i < 6; ++i) { const int idx = tid + 512 * i, rr = idx >> 5, c8 = (idx & 31) * 8, rrel = rr - 30;
        A[i] = (u32x4){0u, 0u, 0u, 0u};
        if (idx < 94 * 32 && (rrel >= 0 || hist)) A[i] = *(const u32x4*)(P + (size_t)(t.g0 + rrel) * DP + PC_Z + c8); }
}
__device__ __forceinline__ int mix_conv_run(const Params& p, int l, const bf16_t* P, bf16_t* MIX, LAS unsigned char* lds, int tid, int u, const int stride, const int uend) {
    LAS float* z = (LAS float*)lds; LAS float* st = (LAS float*)(lds + 94 * 256 * 4);
    const float* SP = (const float*)(p.ws + WS_SMALL);
    const int lane = tid & 63, wave = tid >> 6, c = tid & 255, half = tid >> 8;
    float w[31];
#pragma unroll
    for (int k = 0; k < 31; ++k) w[k] = SP[SP_WDW + (l * 31 + k) * 256 + c];
    const float bias = SP[SP_BDW + l * 256 + c], lg = SP[SP_LNG + l * 256 + c], lb = SP[SP_LNB + l * 256 + c];
    Tile t = prompt_tile(u, 64);
    u32x4 A[6]; conv_loads(t, P, tid, A);
    for (;;) {
        float* oconv = p.out + O_CONVP + (size_t)(l * NBP + t.b) * 30 * 256;
#pragma unroll
        for (int i = 0; i < 6; ++i) { const int idx = tid + 512 * i, rr = idx >> 5, c8 = (idx & 31) * 8, rrel = rr - 30;
            if (idx < 94 * 32) { float zz[8]; unpack8(A[i], zz);
                *(LAS f32x4*)(z + rr * 256 + c8) = (f32x4){zz[0], zz[1], zz[2], zz[3]}; *(LAS f32x4*)(z + rr * 256 + c8 + 4) = (f32x4){zz[4], zz[5], zz[6], zz[7]};
                if (t.last && rrel >= 34) store8f(oconv + (size_t)(rrel - 34) * 256 + c8, zz); } }
        WG_BAR();
        const int un = u + stride; const bool hn = un < uend; const Tile tn = prompt_tile(hn ? un : u, 64);
        if (hn) conv_loads(tn, P, tid, A);
        float cv[4][8];
#pragma unroll
        for (int blk = 0; blk < 4; ++blk) conv_block(z, st, w, bias, half * 32 + blk * 8, c, lane, wave & 3, cv[blk]);
        WG_BAR();
#pragma unroll
        for (int blk = 0; blk < 4; ++blk) { const int r0 = half * 32 + blk * 8; conv_norm(st, cv[blk], r0, lg, lb, MIX + (size_t)(t.g0 + r0) * DM + 256 + c); }
        WG_BAR();
        u = un; if (!hn) break; t = tn;
    }
    return u;
}
__device__ __forceinline__ void pool_loads(const Tile t, const bf16_t* P, int tid, u32x4 (&A)[5]) {
    const bool hist = (t.t0 != 0);
#pragma unroll
    for (int i = 0; i < 5; ++i) { const int idx = tid + 512 * i, rr = idx >> 5, c8 = (idx & 31) * 8, rrel = rr - 15;
        A[i] = (u32x4){0u, 0u, 0u, 0u};
        if (idx < 79 * 32 && (rrel >= 0 || hist)) A[i] = *(const u32x4*)(P + (size_t)(t.g0 + rrel) * DP + c8); }
}
__device__ __forceinline__ int mix_pool_run(const Params& p, int l, const bf16_t* P, bf16_t* MIX, LAS unsigned char* lds, int tid, int u, const int stride, const int uend) {
    LAS float* xs = (LAS float*)lds; LAS bf16_t* pre = (LAS bf16_t*)(lds + 79 * 256 * 4);
    const int lane = tid & 63, wave = tid >> 6, g = wave >> 1, rh = wave & 1, fr = lane & 15, fq = lane >> 4;
    bf16x8 bf[4][2];
    {
        const bf16_t* WPT = (const bf16_t*)(p.ws + WS_WPT) + (size_t)(l * 4 + g) * 64 * 64;
#pragma unroll
        for (int n = 0; n < 4; ++n)
#pragma unroll
            for (int k = 0; k < 2; ++k) bf[n][k] = *(const bf16x8*)(WPT + (16 * n + fr) * 64 + 32 * k + 8 * fq);
    }
    const int c = tid & 255, half = tid >> 8, gg = c >> 6, w = 2 << gg;
    float mk[16];
#pragma unroll
    for (int j = 0; j < 16; ++j) mk[j] = (j < w) ? 1.0f : 0.0f;
    Tile t = prompt_tile(u, 64);
    u32x4 A[5]; pool_loads(t, P, tid, A);
    for (;;) {
        float* opool = p.out + O_POOLP + (size_t)(l * NBP + t.b) * 15 * 256;
#pragma unroll
        for (int i = 0; i < 5; ++i) { const int idx = tid + 512 * i, rr = idx >> 5, c8 = (idx & 31) * 8, rrel = rr - 15;
            if (idx < 79 * 32) { float v[8]; unpack8(A[i], v);
                *(LAS f32x4*)(xs + rr * 256 + c8) = (f32x4){v[0], v[1], v[2], v[3]}; *(LAS f32x4*)(xs + rr * 256 + c8 + 4) = (f32x4){v[4], v[5], v[6], v[7]};
                if (t.last && rrel >= 49) store8f(opool + (size_t)(rrel - 49) * 256 + c8, v); } }
        WG_BAR();
        const int un = u + stride; const bool hn = un < uend; const Tile tn = prompt_tile(hn ? un : u, 64);
        if (hn) pool_loads(tn, P, tid, A);
        for (int r0 = half * 32; r0 < (half + 1) * 32; r0 += 4) {
            float v[19];
#pragma unroll
            for (int i = 0; i < 19; ++i) v[i] = xs[(r0 + i) * 256 + c];
#pragma unroll
            for (int q = 0; q < 4; ++q) { float sm = 0.f;
#pragma unroll
                for (int j = 0; j < 16; ++j) sm += mk[j] * v[q + 15 - j];
                const int pos = t.t0 + r0 + q; const float cnt = (float)((pos + 1 < w) ? pos + 1 : w);
                const float pv = sm * __builtin_amdgcn_rcpf(cnt) - v[q + 15];
                pre[(r0 + q) * 264 + c] = (bf16_t)(pk_bf16(pv, 0.f) & 0xffffu); }
        }
        WG_BAR();
#pragma unroll
        for (int m = 0; m < 2; ++m) {
            const int row = rh * 32 + 16 * m + fr;
            bf16x8 af[2];
#pragma unroll
            for (int k = 0; k < 2; ++k) af[k] = *(const LAS bf16x8*)(pre + row * 264 + g * 64 + 32 * k + 8 * fq);
#pragma unroll
            for (int n = 0; n < 4; ++n) { f32x4 a = {0.f, 0.f, 0.f, 0.f};
#pragma unroll
                for (int k = 0; k < 2; ++k) a = __builtin_amdgcn_mfma_f32_16x16x32_bf16(bf[n][k], af[k], a, 0, 0, 0);
                u32x2 o; o.x = pk_bf16(a[0], a[1]); o.y = pk_bf16(a[2], a[3]);
                *(u32x2*)(MIX + (size_t)(t.g0 + row) * DM + g * 64 + 16 * n + 4 * fq) = o; }
        }
        WG_BAR();
        u = un; if (!hn) break; t = tn;
    }
    return u;
}

constexpr int NU_CONV = MP / 64, NU_POOL = MP / 64, NU_MLP = MP / 128, NU_SC = MP / 64, NU_PROMPT = NU_CONV + NU_POOL + NU_MLP + NU_SC, NU_ALL = NU_PROMPT + 4 * NBS;
__device__ __forceinline__ void mixer_phase(const Params& p, int l, LAS unsigned char* lds, int tid, const int first, const int stride, const int mask = EXP_MIXMASK) {
    const bf16_t* P = (const bf16_t*)(p.ws + WS_P); bf16_t* MIX = (bf16_t*)(p.ws + WS_MIX);
    int u = first;
    asm volatile("" : "+v"(tid));
    if (u < NU_CONV) { const int un = mix_conv_run(p, l, P, MIX, lds, tid, u, stride, NU_CONV); u = un; }
    asm volatile("" : "+v"(tid));
    if (u < NU_CONV + NU_POOL) { const int un = mix_pool_run(p, l, P, MIX, lds, tid, u - NU_CONV, stride, NU_POOL); u = un + NU_CONV; }
    for (; u < NU_PROMPT; u += stride) {
        int r = u - NU_CONV - NU_POOL; asm volatile("" : "+v"(tid));
        {
            const int rn = r + stride;
            if (rn < NU_MLP) { const Tile tn = prompt_tile(rn, 128); const bf16_t* q = P + (size_t)(tn.g0 + (tid >> 2)) * DP + 64 * (tid & 3);
                (void)*(volatile const unsigned*)(q + PC_V); (void)*(volatile const unsigned*)(q + PC_U); }
            else if (rn < NU_MLP + NU_SC) { const Tile tn = prompt_tile(rn - NU_MLP, 64); const int rr = (tid >> 2) - 2;
                if (rr < 64 && (rr >= 0 || tn.t0 != 0)) (void)*(volatile const unsigned*)(P + (size_t)(tn.g0 + rr) * DP + PC_ZS + 64 * (tid & 3));
                if (rr >= 0 && rr < 64) (void)*(volatile const unsigned*)(P + (size_t)(tn.g0 + rr) * DP + PC_B + 64 * (tid & 3)); }
        }
        if (r < NU_MLP) { if (mask & 4) mix_mlp<128>(p, l, prompt_tile(r, 128), P, MIX, lds, tid); continue; } r -= NU_MLP;
        if (mask & 8) mix_sconv(p, l, prompt_tile(r, 64), P, MIX, tid);
    }
}
__device__ __forceinline__ void sample_mixers(const Params& p, int l, LAS unsigned char* lds, int tid, const int first, const int stride) {
    const bf16_t* P = (const bf16_t*)(p.ws + WS_P); bf16_t* MIX = (bf16_t*)(p.ws + WS_MIX);
    for (int r = first; r < 4 * NBS; r += stride) {
        asm volatile("" : "+v"(tid));
        const int b = r & 7, kind = r >> 3;
        if (kind == 0) mix_conv(p, l, sample_tile(b), P, MIX, lds, tid);
        else if (kind == 1) mix_pool(p, l, sample_tile(b), P, MIX, lds, tid);
        else if (kind == 2) mix_mlp<32>(p, l, sample_tile(b), P, MIX, lds, tid);
        else mix_sconv(p, l, sample_tile(b), P, MIX, tid);
    }
}

__device__ __forceinline__ void final_norm(const Params& p, int lane, int wave, const int gw, const int NGW, const int row_lo, const int row_hi) {
    const bf16_t* XB = (const bf16_t*)(p.ws + WS_XB); const float* SSQ = (const float*)(p.ws + WS_SSQA);
    f32x4 g[4];
#pragma unroll
    for (int j = 0; j < 4; ++j) g[j] = ((const f32x4*)(p.ws + WS_SMALL + (size_t)SP_GF * 4))[lane + 64 * j];
    for (int m0 = row_lo + gw; m0 < row_hi; m0 += 4 * NGW) {
        u32x2 v[4][4]; float s[4];
#pragma unroll
        for (int h = 0; h < 4; ++h) { const int m = m0 + h * NGW; const int mm = m < row_hi ? m : m0; const u32x2* xr = (const u32x2*)(XB + (size_t)mm * DM) + lane;
#pragma unroll
            for (int j = 0; j < 4; ++j) v[h][j] = xr[64 * j];
            s[h] = (lane < 16) ? SSQ[(size_t)mm * 16 + lane] : 0.f; }
#pragma unroll
        for (int h = 0; h < 4; ++h) { const int m = m0 + h * NGW; const float rs = rsqrtf(wave_sum(s[h]) * (1.0f / DM) + EPS);
            if (m < row_hi) { f32x4* o = (f32x4*)(p.out + (size_t)m * DM) + lane;
#pragma unroll
                for (int j = 0; j < 4; ++j) { const f32x4 x = {bf_lo(v[h][j].x), bf_hi(v[h][j].x), bf_lo(v[h][j].y), bf_hi(v[h][j].y)}; __builtin_nontemporal_store(x * rs * g[j], &o[64 * j]); } } }
    }
}

#define XB_TMO      128
#define XB_XCNT(j)  (256  + 64 * (j))
#define XB_XSUB(j)  (1280 + 64 * (j))
#define XB_XGEN(j)  (2304 + 64 * (j))
#define XB_TOP      3328
#define XB_TOPGEN   3392
#define XCD_BAR_WORDS 3456
#define XB_SPIN_CAP (1u << 18)

__device__ __forceinline__ unsigned xb_ld(unsigned* p)              { return __hip_atomic_load(p, __ATOMIC_RELAXED, __HIP_MEMORY_SCOPE_AGENT); }
__device__ __forceinline__ unsigned xb_add(unsigned* p, unsigned v) { return __hip_atomic_fetch_add(p, v, __ATOMIC_RELAXED, __HIP_MEMORY_SCOPE_AGENT); }
__device__ __forceinline__ unsigned xb_xcc_id() { return (unsigned)__builtin_amdgcn_s_getreg((3 << 11) | 20) & 0xFu; }
#define XB_SPIN(cond, bar) do { unsigned _sp = 0; while (cond) { __builtin_amdgcn_s_sleep(1); \
    if ((++_sp & 255u) == 0u) { if (xb_ld(&(bar)[XB_TMO])) break; if (_sp > XB_SPIN_CAP) { atomicAdd(&(bar)[XB_TMO], 1u); break; } } } } while (0)

struct XcdBarrier {
    unsigned* bar; unsigned x;
    volatile LAS unsigned* st;
};

__device__ __forceinline__ XcdBarrier xcd_barrier_post(unsigned* bar, volatile LAS unsigned* st) {
    XcdBarrier b; b.bar = bar; b.x = xb_xcc_id(); b.st = st;
    if (threadIdx.x == 0) (void)xb_add(&bar[XB_XCNT(b.x)], 1u);
    return b;
}
__device__ __forceinline__ void xcd_barrier_complete(unsigned* bar, unsigned x, unsigned& nloc, unsigned& nx) {
    const unsigned G = gridDim.x * gridDim.y * gridDim.z;
    unsigned sum, cnt, mine, sp = 0u;
    for (;;) {
        sum = 0u; cnt = 0u; mine = 0u;
#pragma unroll
        for (unsigned j = 0; j < 16; ++j) { const unsigned c = xb_ld(&bar[XB_XCNT(j)]); sum += c; cnt += (c > 0u) ? 1u : 0u; mine = (j == x) ? c : mine; }
        if (sum == G) break;
        __builtin_amdgcn_s_sleep(1);
        if ((++sp & 255u) == 0u) { if (xb_ld(&bar[XB_TMO])) break; if (sp > XB_SPIN_CAP) { atomicAdd(&bar[XB_TMO], 1u); break; } }
    }
    nloc = mine > 0u ? mine : 1u; nx = cnt > 0u ? cnt : 1u;
}

__device__ __forceinline__ void xcd_barrier(const XcdBarrier& b) {
    asm volatile("s_waitcnt vmcnt(0)" ::: "memory");
    __syncthreads();
    if (pg8::pg8_tid((LAS unsigned char*)b.st - 131072) == 0) {
        unsigned* bar = b.bar;
        __builtin_amdgcn_s_waitcnt(0);
        unsigned nloc = b.st[0], nx = b.st[1];
        if (nloc == 0u) { xcd_barrier_complete(bar, b.x, nloc, nx); b.st[0] = nloc; b.st[1] = nx; }
        const unsigned old = xb_add(&bar[XB_XSUB(b.x)], 1u);
        const unsigned gen = old / nloc;
        if (old + 1u == (gen + 1u) * nloc) {
            __builtin_amdgcn_fence(__ATOMIC_RELEASE, "agent");
            asm volatile("s_waitcnt vmcnt(0)" ::: "memory");
            const unsigned og = xb_add(&bar[XB_TOP], 1u);
            const unsigned tg = og / nx;
            if (og + 1u == (tg + 1u) * nx) xb_add(&bar[XB_TOPGEN], 1u);
            else XB_SPIN(xb_ld(&bar[XB_TOPGEN]) == tg, bar);
            __builtin_amdgcn_fence(__ATOMIC_ACQUIRE, "agent");
            xb_add(&bar[XB_XGEN(b.x)], 1u);
            asm volatile("s_waitcnt vmcnt(0)" ::: "memory");
        } else {
            XB_SPIN(xb_ld(&bar[XB_XGEN(b.x)]) == gen, bar);
            __builtin_amdgcn_fence(__ATOMIC_ACQUIRE, "agent");
            asm volatile("s_waitcnt vmcnt(0)" ::: "memory");
        }
    }
    __syncthreads();
}


constexpr int NSG = 22;
struct SampleOrder {
    int nN, c;
    __device__ __forceinline__ bool next(int i, pg8::Unit& u) const { const int j = i * NSG + c; if (j >= nN) return false; u.pm = MP / 256; u.pn = j; return true; }
    __device__ __forceinline__ void a_ready(const pg8::Unit&) const {}
    __device__ __forceinline__ void done(const pg8::Unit&) const {}
};
__device__ __forceinline__ void group_barrier(unsigned* ctr, unsigned target, unsigned* tmo, int tid) {
    asm volatile("s_waitcnt vmcnt(0)" ::: "memory");
    __syncthreads();
    if (tid == 0) {
        __builtin_amdgcn_fence(__ATOMIC_RELEASE, "agent");
        asm volatile("s_waitcnt vmcnt(0)" ::: "memory");
        (void)__hip_atomic_fetch_add(ctr, 1u, __ATOMIC_RELAXED, __HIP_MEMORY_SCOPE_AGENT);
        unsigned sp = 0;
        while (__hip_atomic_load(ctr, __ATOMIC_RELAXED, __HIP_MEMORY_SCOPE_AGENT) < target) { __builtin_amdgcn_s_sleep(1);
            if ((++sp & 255u) == 0u) { if (__hip_atomic_load(tmo, __ATOMIC_RELAXED, __HIP_MEMORY_SCOPE_AGENT)) break; if (sp > (1u << 20)) { atomicAdd(tmo, 1u); break; } } }
        __builtin_amdgcn_fence(__ATOMIC_ACQUIRE, "agent");
        asm volatile("s_waitcnt vmcnt(0)" ::: "memory");
    }
    __syncthreads();
}


struct EpiSwiGLUS {
    static constexpr bool PERM = true, AFTER_DRAIN = false;
    bf16_t* H; const float* ssq;
    __device__ __forceinline__ void operator()(const f32x4 (&acc)[2][2][4][2], const pg8::Unit& u, int wr, int wc, int fr, int fq) const {
        asm volatile("" : "+v"(fr));
        const int row0 = u.pm * 256 + wr * 64 + fr, lrow0 = wr * 64 + fr, kh = u.pn / 11, col0 = (u.pn - 11 * kh) * 128 + wc * 32 + 8 * fq;
        bf16_t* Hh = H + (size_t)kh * MS * KH;
#pragma unroll
        for (int ai = 0; ai < 2; ++ai)
#pragma unroll
            for (int m = 0; m < 4; ++m) {
                const int row = row0 + ai * 128 + m * 16; const float rs = row_rstd(ssq, row, fq);
                float h[8];
                const float c1 = rs * -1.4426950408889634f, rs2 = rs * rs;
#pragma unroll
                for (int n = 0; n < 2; ++n)
#pragma unroll
                    for (int j = 0; j < 4; j += 2) { const f32x2 ag = {acc[ai][0][m][n][j], acc[ai][0][m][n][j + 1]}, au = {acc[ai][1][m][n][j], acc[ai][1][m][n][j + 1]};
                        const f32x2 t = ag * c1; f32x2 e; e.x = __builtin_amdgcn_exp2f(t.x); e.y = __builtin_amdgcn_exp2f(t.y);
                        const f32x2 d = e + 1.0f; f32x2 r; r.x = __builtin_amdgcn_rcpf(d.x); r.y = __builtin_amdgcn_rcpf(d.y);
                        const f32x2 hh = (ag * au) * (r * rs2); h[n * 4 + j] = hh.x; h[n * 4 + j + 1] = hh.y; }
                u32x4 w; w.x = pk_bf16(h[0], h[1]); w.y = pk_bf16(h[2], h[3]); w.z = pk_bf16(h[4], h[5]); w.w = pk_bf16(h[6], h[7]);
                *(u32x4*)(Hh + (size_t)(lrow0 + ai * 128 + m * 16) * KH + col0) = w;
            }
    }
};
struct EpiPart {
    static constexpr bool PERM = false, AFTER_DRAIN = false;
    float* part;
    __device__ __forceinline__ void operator()(const f32x4 (&acc)[2][2][4][2], const pg8::Unit& u, int wr, int wc, int fr, int fq) const {
        asm volatile("" : "+v"(fr));
        const int lrow0 = wr * 64 + fr, col0 = u.pn * 256 + wc * 32 + 4 * fq;
#pragma unroll
        for (int ai = 0; ai < 2; ++ai)
#pragma unroll
            for (int m = 0; m < 4; ++m)
#pragma unroll
                for (int bj = 0; bj < 2; ++bj)
#pragma unroll
                    for (int n = 0; n < 2; ++n) *(f32x4*)(part + (size_t)(lrow0 + ai * 128 + m * 16) * DM + col0 + bj * 128 + n * 16) = acc[ai][bj][m][n];
    }
};
struct SampleOrderD {
    int c;
    __device__ __forceinline__ bool next(int i, pg8::Unit& u) const { if (i > 0 || c >= 8) return false; u.pm = 0; u.pn = c & 3; return true; }
    __device__ __forceinline__ void a_ready(const pg8::Unit&) const {}
    __device__ __forceinline__ void done(const pg8::Unit&) const {}
};
__device__ __forceinline__ void sample_combine(const Params& p, int lane, int gw, int NGW, float* ssq) {
    bf16_t* XB = (bf16_t*)(p.ws + WS_XB) + (size_t)MP * DM; const float* P0 = (const float*)(p.ws + WS_PART); const float* P1 = P0 + (size_t)MS * DM;
    for (int r = gw; r < MS; r += NGW) {
        u32x2* xr = (u32x2*)(XB + (size_t)r * DM) + lane; const f32x4* a = (const f32x4*)(P0 + (size_t)r * DM) + lane; const f32x4* b = (const f32x4*)(P1 + (size_t)r * DM) + lane;
        float q = 0.f;
#pragma unroll
        for (int j = 0; j < 4; ++j) { const u32x2 w = xr[64 * j]; const f32x4 x = (f32x4){bf_lo(w.x), bf_hi(w.x), bf_lo(w.y), bf_hi(w.y)} + a[64 * j] + b[64 * j];
            q += (x[0] * x[0] + x[1] * x[1]) + (x[2] * x[2] + x[3] * x[3]); u32x2 o; o.x = pk_bf16(x[0], x[1]); o.y = pk_bf16(x[2], x[3]); xr[64 * j] = o; }
        q = wave_sum(q);
        if (lane < 16) ssq[(size_t)(MP + r) * 16 + lane] = (lane == 0) ? q : 0.f;
    }
}


__global__ void __launch_bounds__(512, 2) fwd_megakernel(Params p) {
    extern __shared__ __attribute__((aligned(16))) unsigned char lds_raw[];
    LAS unsigned char* lds = (LAS unsigned char*)lds_raw;
    const int G = gridDim.x, bx = blockIdx.x;
#define MYTID() pg8::pg8_tid(lds)
#define LWS(name) size_t name##_z = 0; asm volatile("" : "+s"(name##_z)); unsigned char* name = p.ws + name##_z
#define SAMPLE_DOWN(L) do { \
            { LWS(ws); const int kh = (bx >> 2) & 1; \
              pg8::Gemm g{(const bf16_t*)(ws + WS_HIDS) + (size_t)kh * MS * KH, (const bf16_t*)(ws + WS_WDNS) + (size_t)((L) * 2 + kh) * DM * KH, MS, DM, KH}; SampleOrderD S{bx}; \
              EpiPart E{(float*)(ws + WS_PART) + (size_t)kh * MS * DM}; pg8::gemm_phase<EpiPart, SampleOrderD, true, true>(lds, g, S, E); } \
            { LWS(ws); group_barrier((unsigned*)(ws + WS_CTL) + 3584, NSG * (++ep), (unsigned*)(ws + WS_CTL) + 3648, MYTID()); } \
            { LWS(ws); const int t_ = MYTID(); sample_combine(p, t_ & 63, bx * 8 + (t_ >> 6), NSG * 8, (float*)(ws + WS_SSQA)); } } while (0)
#define GRID_SYNC() do { XcdBarrier b_ = bar; asm volatile("" : "+s"(b_.x)); LWS(w_); b_.bar = (unsigned*)(w_ + WS_CTL); xcd_barrier(b_); } while (0)
    { const int tid0 = threadIdx.x; volatile LAS unsigned* stw = (volatile LAS unsigned*)(lds + 131072); if (tid0 < 64) stw[tid0] = 0u;
      if (tid0 < 8) ((volatile LAS int*)(lds + LDS_RC + 4096))[tid0] = 0;
      if ((tid0 & 63) == 0) ((volatile LAS int*)(lds + 131072 + 256))[(int)__builtin_amdgcn_s_getreg((5 << 11) | 4) & 63] = tid0 >> 6; }
    __syncthreads();
    XcdBarrier bar = xcd_barrier_post((unsigned*)(p.ws + WS_CTL), (volatile LAS unsigned*)(lds + 131072));
    cg::this_grid().sync();
    { const int t_ = MYTID(); prologue(p, lds, t_, t_ & 63, t_ >> 6); convert_rows(p, t_ & 63, bx * 8 + (t_ >> 6), G * 8, MP, MT); }
    GRID_SYNC();
    constexpr int NI0 = DIN / 256;
    if (bx >= NI0) { int t_ = MYTID(); asm volatile("" : "+v"(t_)); convert_rows(p, t_ & 63, (bx - NI0) * 8 + (t_ >> 6), (G - NI0) * 8, 0, MP); }
    else { LWS(ws); pg8::Gemm g{(const bf16_t*)(ws + WS_XB), (const bf16_t*)(ws + WS_WIN), MT, DIN, DM}; SampleOrder S{DIN / 256, bx}; EpiInProj E{(bf16_t*)(ws + WS_P), (const float*)(ws + WS_SSQA), (LAS float*)(lds + LDS_RC), 9};
      pg8::gemm_phase<EpiInProj, SampleOrder, true, true>(lds, g, S, E); }
    GRID_SYNC();
#pragma unroll 1
    for (int l = 0; l < 2; ++l) {
        {
            LWS(ws);
            pg8::Gemm g{(const bf16_t*)(ws + WS_XB), (const bf16_t*)(ws + WS_WIN) + (size_t)l * DIN * DM, MP, DIN, DM}; pg8::StaticOrder S; S.init(MP, DIN, G, bx); S.wgm = 16;
            EpiInProj E{(bf16_t*)(ws + WS_P), (const float*)(ws + WS_SSQA), (LAS float*)(lds + LDS_RC), 1 + 2 * l};
            pg8::gemm_phase<EpiInProj, pg8::StaticOrder, true, true>(lds, g, S, E);
        }
        GRID_SYNC();
        if (bx >= NSG) mixer_phase(p, l, lds, MYTID(), bx - NSG, G - NSG);
        else {
            unsigned ep = 4u * (unsigned)l;
            if (l == 1) {
              { LWS(ws); pg8::Gemm g{(const bf16_t*)(ws + WS_XB), (const bf16_t*)(ws + WS_WIN) + (size_t)DIN * DM, MT, DIN, DM}; SampleOrder S{DIN / 256, bx}; EpiInProj E{(bf16_t*)(ws + WS_P), (const float*)(ws + WS_SSQA), (LAS float*)(lds + LDS_RC), 10};
                pg8::gemm_phase<EpiInProj, SampleOrder, true, true>(lds, g, S, E); }
              { LWS(ws); group_barrier((unsigned*)(ws + WS_CTL) + 3584, NSG * (++ep), (unsigned*)(ws + WS_CTL) + 3648, MYTID()); }
            }
            sample_mixers(p, l, lds, MYTID(), bx, NSG);
            { LWS(ws); group_barrier((unsigned*)(ws + WS_CTL) + 3584, NSG * (++ep), (unsigned*)(ws + WS_CTL) + 3648, MYTID()); }
            { LWS(ws); pg8::Gemm g{(const bf16_t*)(ws + WS_MIX), (const bf16_t*)(ws + WS_WOUT) + (size_t)l * DM * DM, MT, DM, DM}; SampleOrder S{DM / 256, bx};
              EpiResid E{nullptr, (bf16_t*)(ws + WS_XB), (float*)(ws + WS_SSQB)}; pg8::gemm_phase<EpiResid, SampleOrder, true, true>(lds, g, S, E); }
            { LWS(ws); group_barrier((unsigned*)(ws + WS_CTL) + 3584, NSG * (++ep), (unsigned*)(ws + WS_CTL) + 3648, MYTID()); }
            { LWS(ws); pg8::Gemm g{(const bf16_t*)(ws + WS_XB), (const bf16_t*)(ws + WS_WGU) + (size_t)l * NGU * DM, MT, NGU, DM}; SampleOrder S{NGU / 256, bx};
              EpiSwiGLUS E{(bf16_t*)(ws + WS_HIDS), (const float*)(ws + WS_SSQB)}; pg8::gemm_phase<EpiSwiGLUS, SampleOrder, true, true>(lds, g, S, E); }
            if (l == 0) {
                { LWS(ws); group_barrier((unsigned*)(ws + WS_CTL) + 3584, NSG * (++ep), (unsigned*)(ws + WS_CTL) + 3648, MYTID()); }
                SAMPLE_DOWN(0);
            }
        }
        GRID_SYNC();
        {
            LWS(ws);
            pg8::Gemm g{(const bf16_t*)(ws + WS_MIX), (const bf16_t*)(ws + WS_WOUT) + (size_t)l * DM * DM, MP, DM, DM}; pg8::StaticOrder S; S.init(MP, DM, G, bx);
            EpiResid E{nullptr, (bf16_t*)(ws + WS_XB), (float*)(ws + WS_SSQB)};
            pg8::gemm_phase<EpiResid, pg8::StaticOrder, true, true>(lds, g, S, E);
        }
        GRID_SYNC();
        {
            LWS(ws);
            pg8::Gemm g{(const bf16_t*)(ws + WS_XB), (const bf16_t*)(ws + WS_WGU) + (size_t)l * NGU * DM, MP, NGU, DM}; pg8::StaticOrder S; S.init(MP, NGU, G, bx);
            EpiSwiGLU E{(bf16_t*)(ws + WS_HID), (const float*)(ws + WS_SSQB), (LAS float*)(lds + LDS_RC), 2 + 2 * l};
            pg8::gemm_phase<EpiSwiGLU, pg8::StaticOrder, true, true>(lds, g, S, E);
        }
        GRID_SYNC();
        {
            LWS(ws);
            pg8::Gemm g{(const bf16_t*)(ws + WS_HID), (const bf16_t*)(ws + WS_WDN) + (size_t)l * DM * DFF, MP, DM, DFF}; pg8::StaticOrder S; S.init(MP, DM, G, bx);
            EpiResid E{nullptr, (bf16_t*)(ws + WS_XB), (float*)(ws + WS_SSQA)};
            pg8::gemm_phase<EpiResid, pg8::StaticOrder, true, true>(lds, g, S, E);
        }
        GRID_SYNC();
    }
    if (bx >= NSG) { int t2 = MYTID(); asm volatile("" : "+v"(t2)); final_norm(p, t2 & 63, t2 >> 6, (bx - NSG) * 8 + (t2 >> 6), (G - NSG) * 8, 0, MP); }
    else {
        unsigned ep = 7u;
        SAMPLE_DOWN(1);
        { LWS(ws); group_barrier((unsigned*)(ws + WS_CTL) + 3584, NSG * (++ep), (unsigned*)(ws + WS_CTL) + 3648, MYTID()); }
        { int t2 = MYTID(); asm volatile("" : "+v"(t2)); final_norm(p, t2 & 63, t2 >> 6, bx * 8 + (t2 >> 6), NSG * 8, MP, MT); }
    }
}

extern "C" void kernel_launch(void* const* d_in, const int* in_sizes, int n_in, void* d_out, int out_size, void* d_ws, size_t ws_size, hipStream_t stream) {
    static int grid = 0;
    if (grid == 0) {
        if ((size_t)out_size != O_END) fprintf(stderr, "kernel_launch: note: out_size %d, expected %zu\n", out_size, (size_t)O_END);
        if (n_in != 22 || in_sizes[0] != MP * DM || ws_size < WS_END) {
            fprintf(stderr, "kernel_launch: unexpected shapes: n_in %d in0 %d out %d ws %zu (need %zu)\n", n_in, n_in > 0 ? in_sizes[0] : -1, out_size, ws_size, (size_t)WS_END); grid = -1; return; }
        int dev = 0, cus = 0, per_cu = 0;
        (void)hipGetDevice(&dev); (void)hipDeviceGetAttribute(&cus, hipDeviceAttributeMultiprocessorCount, dev);
        if (hipFuncSetAttribute((const void*)fwd_megakernel, hipFuncAttributeMaxDynamicSharedMemorySize, LDS_BYTES) != hipSuccess) { fprintf(stderr, "kernel_launch: hipFuncSetAttribute failed\n"); grid = -1; return; }
        if (hipOccupancyMaxActiveBlocksPerMultiprocessor(&per_cu, (const void*)fwd_megakernel, 512, LDS_BYTES) != hipSuccess || per_cu < 1) { fprintf(stderr, "kernel_launch: occupancy query says %d blocks per CU\n", per_cu); per_cu = 1; }
        (void)hipGetLastError();
        grid = cus * per_cu;
    }
    if (grid < 0) return;
    if (hipMemsetAsync((char*)d_ws + WS_CTL, 0, CTL_BYTES, stream) != hipSuccess) { fprintf(stderr, "kernel_launch: memset failed\n"); return; }
    Params p{};
    const float** pp = (const float**)&p;
    for (int i = 0; i < 22; ++i) pp[i] = (const float*)d_in[i];
    p.out = (float*)d_out; p.ws = (unsigned char*)d_ws;
    void* args[] = {&p};
    hipError_t e = hipLaunchCooperativeKernel((const void*)fwd_megakernel, dim3(grid), dim3(512), args, LDS_BYTES, stream);
    if (e != hipSuccess) fprintf(stderr, "kernel_launch: cooperative launch failed: %s (grid %d)\n", hipGetErrorString(e), grid);
}
```

```cpp
#include <hip/hip_runtime.h>
#include <hip/hip_cooperative_groups.h>
#include <cstdio>
#include <cstdint>
namespace cg = cooperative_groups;
namespace pg8 {
#define PG8_LAS __attribute__((address_space(3)))
typedef unsigned short bf16_t;
typedef short bf16x8 __attribute__((ext_vector_type(8)));
typedef float f32x4 __attribute__((ext_vector_type(4)));
typedef unsigned u32x4 __attribute__((ext_vector_type(4)));
constexpr int BM = 256, BK = 64, HALF = 128, HTB = HALF * BK * 2  , STAGE_BYTES = 8 * HTB, NXCD = 8, WGM = 8;

__host__ __device__ __forceinline__ int lds_byte(int r, int c) { const int st = (r >> 4) * 2 + (c >> 5), rr = r & 15, cc = c & 31, ob = rr * 64 + cc * 2; return st * 1024 + (ob ^ (((ob >> 9) & 1) << 5)); }
__host__ __device__ __forceinline__ void stage_rc(int b, int& R, int& C) { const int st = b / 1024, sb = b % 1024, swz = sb ^ (((sb >> 9) & 1) << 5); R = (st >> 1) * 16 + swz / 64; C = (st & 1) * 32 + (swz % 64) / 2; }
__host__ __device__ __forceinline__ int perm32(int rho) { const int n = rho >> 4, i = rho & 15; return 8 * (i >> 2) + 4 * n + (i & 3); }

struct Unit { int pm, pn; };
struct Gemm { const bf16_t* A; const bf16_t* Bt; int M, N, K; };

struct StaticOrder {
    int nM, nN, nwg, G, c, wgm = WGM;
    __host__ __device__ void init(int M, int N, int G_, int c_) { nM = M / BM; nN = N / BM; nwg = nM * nN; G = G_; c = c_; }
    __host__ __device__ bool next(int i, Unit& u) const {
        const long L = (long)i * G + c; if (L >= nwg) return false;
        int wgid = (int)L; { const int q = nwg / NXCD, r = nwg % NXCD, xcd = wgid % NXCD, off = wgid / NXCD; wgid = (xcd < r ? xcd * (q + 1) : r * (q + 1) + (xcd - r) * q) + off; }
        const int nig = wgm * nN, gid = wgid / nig, fm = gid * wgm, gsz = (nM - fm) < wgm ? (nM - fm) : wgm;
        u.pm = fm + ((wgid % nig) % gsz); u.pn = (wgid % nig) / gsz; return true;
    }
    __device__ __forceinline__ void a_ready(const Unit&) const {}
    __device__ __forceinline__ void done(const Unit&) const {}
};
__device__ __forceinline__ unsigned cvt_pk_bf16(float lo, float hi) { unsigned r; asm volatile("v_cvt_pk_bf16_f32 %0, %1, %2" : "=v"(r) : "v"(lo), "v"(hi)); return r; }
typedef float f32x2 __attribute__((ext_vector_type(2)));
__device__ __forceinline__ int pg8_tid(PG8_LAS unsigned char* lds) {
    const int slot = (int)__builtin_amdgcn_s_getreg((5 << 11) | 4) & 63;
    const int w = ((volatile PG8_LAS int*)(lds + 131072 + 256))[slot];
    return __builtin_amdgcn_readfirstlane(w) * 64 + (int)__builtin_amdgcn_mbcnt_hi(~0u, __builtin_amdgcn_mbcnt_lo(~0u, 0u));
}
template <class Epi, class Sched, bool ALIGN_EPI = false, bool SP2 = false>
__device__ __forceinline__ void gemm_phase(PG8_LAS unsigned char* lds, const Gemm g, const Sched& S, const Epi& E) {
    int tid_l = pg8_tid(lds); asm volatile("" : "+v"(tid_l));
    const int tid = tid_l, wid = __builtin_amdgcn_readfirstlane(tid >> 6), lane = tid & 63, wr = wid >> 2, wc = wid & 3, fr = lane & 15, fq = lane >> 4;
    const int K = g.K, nt = K / BK;
    unsigned voffA[2], voffB[2];
#pragma unroll
    for (int i = 0; i < 2; ++i) { int R, C; stage_rc(tid * 16 + i * 8192, R, C); const int Rb = Epi::PERM ? ((R & ~31) + perm32(R & 31)) : R;
        voffA[i] = (unsigned)(R * K + C) * 2u; voffB[i] = (unsigned)(Rb * K + C) * 2u; }
    const size_t kstep = (size_t)(BK * 2);
    const size_t hstep = (size_t)HALF * K * 2;
    const size_t tstep = 2 * hstep;
    const unsigned ldsw = (unsigned)wid * 1024u;
    const int aoff = lds_byte(wr * 64 + fr, fq * 8), boff = lds_byte(wc * 32 + fr, fq * 8);
#define PG8_SA(b, h) (((b) * 2 + (h)) * HTB)
#define PG8_SB(b, h) ((4 + (b) * 2 + (h)) * HTB)
#define PG8_STAGE(bufoff, gbase, voff) do { _Pragma("unroll") for (int _i = 0; _i < 2; ++_i) \
        __builtin_amdgcn_global_load_lds((const unsigned*)((const char*)(gbase) + (voff)[_i]), (PG8_LAS unsigned*)(lds + (bufoff) + ldsw + _i * 8192), 16, 0, 0); } while (0)
#define PG8_LDA(dst, b, h) do { _Pragma("unroll") for (int m = 0; m < 4; ++m) _Pragma("unroll") for (int k = 0; k < 2; ++k) dst[m][k] = *(const PG8_LAS bf16x8*)(lds + PG8_SA(b, h) + aoff + m * 2048 + k * 1024); } while (0)
#define PG8_LDB(dst, b, h) do { _Pragma("unroll") for (int n = 0; n < 2; ++n) _Pragma("unroll") for (int k = 0; k < 2; ++k) dst[n][k] = *(const PG8_LAS bf16x8*)(lds + PG8_SB(b, h) + boff + n * 2048 + k * 1024); } while (0)
#define PG8_MMA(ai, bj, At, Bt) do { __builtin_amdgcn_s_setprio(1); _Pragma("unroll") for (int m = 0; m < 4; ++m) _Pragma("unroll") for (int n = 0; n < 2; ++n) _Pragma("unroll") for (int k = 0; k < 2; ++k) \
        acc[ai][bj][m][n] = __builtin_amdgcn_mfma_f32_16x16x32_bf16(Bt[n][k], At[m][k], acc[ai][bj][m][n], 0, 0, 0); __builtin_amdgcn_s_setprio(0); } while (0)
#define PG8_WAIT_V(n) asm volatile("s_waitcnt vmcnt(" #n ")" ::: "memory")
#define PG8_WAIT_L(n) asm volatile("s_waitcnt lgkmcnt(" #n ")" ::: "memory")
#define PG8_BAR __builtin_amdgcn_s_barrier()
#define PG8_SCHED __builtin_amdgcn_sched_barrier(0)
    Unit cur, nxt; int ui = 0;
    if (!S.next(0, cur)) return;
    f32x4 acc[2][2][4][2];
#pragma unroll
    for (int a = 0; a < 2; ++a)
#pragma unroll
        for (int b = 0; b < 2; ++b)
#pragma unroll
            for (int m = 0; m < 4; ++m)
#pragma unroll
                for (int n = 0; n < 2; ++n) acc[a][b][m][n] = (f32x4){0.f, 0.f, 0.f, 0.f};
    bf16x8 At[4][2], B0[2][2], B1[2][2];
    const char* cA = (const char*)g.A + (size_t)cur.pm * tstep; const char* cB = (const char*)g.Bt + (size_t)cur.pn * tstep;
    S.a_ready(cur);
    if constexpr (SP2) {
        PG8_STAGE(PG8_SB(0, 0), cB, voffB); PG8_STAGE(PG8_SB(0, 1), cB + hstep, voffB); PG8_STAGE(PG8_SA(0, 0), cA, voffA); PG8_STAGE(PG8_SA(0, 1), cA + hstep, voffA);
        if (wr == 1) PG8_BAR;
        PG8_WAIT_V(2); PG8_BAR;
        PG8_STAGE(PG8_SB(1, 0), cB + kstep, voffB); PG8_STAGE(PG8_SA(1, 0), cA + kstep, voffA); PG8_STAGE(PG8_SB(1, 1), cB + hstep + kstep, voffB);
        PG8_WAIT_V(6); PG8_BAR;
    } else {
        PG8_STAGE(PG8_SB(0, 0), cB, voffB); PG8_STAGE(PG8_SA(0, 0), cA, voffA); PG8_STAGE(PG8_SB(0, 1), cB + hstep, voffB); PG8_STAGE(PG8_SA(0, 1), cA + hstep, voffA);
        if (wr == 1) PG8_BAR;
        PG8_WAIT_V(4); PG8_BAR;
        PG8_STAGE(PG8_SB(1, 0), cB + kstep, voffB); PG8_STAGE(PG8_SA(1, 0), cA + kstep, voffA); PG8_STAGE(PG8_SB(1, 1), cB + hstep + kstep, voffB);
        PG8_WAIT_V(6); PG8_BAR;
    }
    for (;;) {
        const bool has_next = S.next(ui + 1, nxt);
        const char* nA = has_next ? (const char*)g.A + (size_t)nxt.pm * tstep : cA; const char* nB = has_next ? (const char*)g.Bt + (size_t)nxt.pn * tstep : cB;
        for (int t = 0; t < nt; t += 2) {
            const bool last = (t == nt - 2);
            const char* a1 = cA + (size_t)(t + 1) * kstep;
            const char* a2 = last ? nA : cA + (size_t)(t + 2) * kstep; const char* b2 = last ? nB : cB + (size_t)(t + 2) * kstep;
            const char* a3 = a2 + kstep; const char* b3 = b2 + kstep;
            if (last && has_next) S.a_ready(nxt);
            if constexpr (SP2) {
            PG8_LDB(B0, 0, 0); PG8_LDB(B1, 0, 1); PG8_SCHED; PG8_LDA(At, 0, 0); PG8_STAGE(PG8_SA(1, 1), a1 + hstep, voffA);
            PG8_WAIT_V(8); PG8_WAIT_L(0); PG8_BAR; PG8_MMA(0, 0, At, B0); PG8_MMA(0, 1, At, B1); PG8_BAR; PG8_SCHED;
            PG8_LDA(At, 0, 1); PG8_STAGE(PG8_SB(0, 0), b2, voffB); PG8_STAGE(PG8_SB(0, 1), b2 + hstep, voffB); PG8_STAGE(PG8_SA(0, 0), a2, voffA);
            PG8_WAIT_V(8); PG8_WAIT_L(0); PG8_BAR; PG8_MMA(1, 0, At, B0); PG8_MMA(1, 1, At, B1); PG8_BAR; PG8_SCHED;
            PG8_LDB(B0, 1, 0); PG8_LDB(B1, 1, 1); PG8_SCHED; PG8_LDA(At, 1, 0); PG8_STAGE(PG8_SA(0, 1), a2 + hstep, voffA);
            PG8_WAIT_V(8); PG8_WAIT_L(0); PG8_BAR; PG8_MMA(0, 0, At, B0); PG8_MMA(0, 1, At, B1); PG8_BAR; PG8_SCHED;
            PG8_LDA(At, 1, 1); PG8_STAGE(PG8_SB(1, 0), b3, voffB); PG8_STAGE(PG8_SB(1, 1), b3 + hstep, voffB); PG8_STAGE(PG8_SA(1, 0), a3, voffA);
            PG8_WAIT_V(8); PG8_WAIT_L(0); PG8_BAR; PG8_MMA(1, 0, At, B0); PG8_MMA(1, 1, At, B1); PG8_BAR; PG8_SCHED;
            } else {
            PG8_LDB(B0, 0, 0); PG8_SCHED; PG8_LDA(At, 0, 0); PG8_STAGE(PG8_SA(1, 1), a1 + hstep, voffA);
            PG8_WAIT_L(8); PG8_BAR; PG8_WAIT_L(0); PG8_MMA(0, 0, At, B0); PG8_BAR; PG8_SCHED;
            PG8_LDB(B1, 0, 1); PG8_STAGE(PG8_SB(0, 0), b2, voffB);
            PG8_BAR; PG8_WAIT_L(0); PG8_MMA(0, 1, At, B1); PG8_BAR;
            PG8_LDA(At, 0, 1); PG8_STAGE(PG8_SA(0, 0), a2, voffA);
            PG8_BAR; PG8_WAIT_L(0); PG8_MMA(1, 0, At, B0); PG8_BAR; PG8_SCHED;
            PG8_STAGE(PG8_SB(0, 1), b2 + hstep, voffB);
            PG8_WAIT_V(6); PG8_BAR; PG8_MMA(1, 1, At, B1); PG8_BAR;
            PG8_LDB(B0, 1, 0); PG8_SCHED; PG8_LDA(At, 1, 0); PG8_STAGE(PG8_SA(0, 1), a2 + hstep, voffA);
            PG8_WAIT_L(8); PG8_BAR; PG8_WAIT_L(0); PG8_MMA(0, 0, At, B0); PG8_BAR; PG8_SCHED;
            PG8_LDB(B1, 1, 1); PG8_STAGE(PG8_SB(1, 0), b3, voffB);
            PG8_BAR; PG8_WAIT_L(0); PG8_MMA(0, 1, At, B1); PG8_BAR;
            PG8_LDA(At, 1, 1); PG8_STAGE(PG8_SA(1, 0), a3, voffA);
            PG8_BAR; PG8_WAIT_L(0); PG8_MMA(1, 0, At, B0); PG8_BAR; PG8_SCHED;
            PG8_STAGE(PG8_SB(1, 1), b3 + hstep, voffB);
            PG8_WAIT_V(6); PG8_BAR; PG8_MMA(1, 1, At, B1); PG8_BAR;
            }
        }
        if constexpr (ALIGN_EPI) { if (wr == 0) PG8_BAR; }
        if constexpr (!Epi::AFTER_DRAIN) { E(acc, cur, wr, wc, fr, fq); S.done(cur); }
        if (!has_next) break;
#pragma unroll
        for (int a = 0; a < 2; ++a)
#pragma unroll
            for (int b = 0; b < 2; ++b)
#pragma unroll
                for (int m = 0; m < 4; ++m)
#pragma unroll
                    for (int n = 0; n < 2; ++n) acc[a][b][m][n] = (f32x4){0.f, 0.f, 0.f, 0.f};
        cur = nxt; cA = nA; cB = nB; ++ui;
        if constexpr (ALIGN_EPI) { if (wr == 1) PG8_BAR; }
    }
    PG8_WAIT_V(0);
    if constexpr (!ALIGN_EPI) { if (wr == 0) PG8_BAR; }
    PG8_BAR;
    if constexpr (Epi::AFTER_DRAIN) { E.fused(acc, cur, wr, wc, fr, fq, lds, wid, lane); S.done(cur); }
#undef PG8_SA
#undef PG8_SB
#undef PG8_STAGE
#undef PG8_LDA
#undef PG8_LDB
#undef PG8_MMA
#undef PG8_WAIT_V
#undef PG8_WAIT_L
#undef PG8_BAR
#undef PG8_SCHED
}
}

#ifndef EXP_MIXMASK
#define EXP_MIXMASK 15
#endif
#ifndef EXP_DUPMASK
#define EXP_DUPMASK 15
#endif
#ifndef EXP_DUP
#define EXP_DUP 0
#endif
#ifndef EXP_STOP
#define EXP_STOP 10
#endif
#define LAS __attribute__((address_space(3)))
typedef unsigned short bf16_t;
typedef float f32x4 __attribute__((ext_vector_type(4)));
typedef float f32x2 __attribute__((ext_vector_type(2)));
typedef unsigned u32x4 __attribute__((ext_vector_type(4)));
typedef unsigned u32x2 __attribute__((ext_vector_type(2)));
typedef short bf16x8 __attribute__((ext_vector_type(8)));

constexpr int DM = 1024, NBP = 16, SEQ = 4096, MP = NBP * SEQ, NBS = 8, DSQ = 32, MS = NBS * DSQ, MT = MP + MS;
constexpr int DIN = 2048, DP = 1536, PC_Z = 256, PC_ZS = 512, PC_B = 768, PC_U = 1024, PC_V = 1280, DFF = 2816, NGU = 2 * DFF, WG = 256, PAST = 1024;
constexpr float EPS = 1e-6f;
constexpr size_t MiB = 1u << 20;
constexpr size_t WS_WIN = 0, WS_WOUT = 8 * MiB, WS_WGU = 12 * MiB, WS_WDN = 34 * MiB, WS_WPT = 45 * MiB, WS_WST = 45 * MiB + 65536;
constexpr size_t WS_SSQA = 46 * MiB, WS_SSQB = 51 * MiB, WS_SMALL = 56 * MiB, WS_CTL = 60 * MiB, CTL_BYTES = 16384, WS_HIDS = 61 * MiB;
constexpr int SP_WDW = 0, SP_BDW = SP_WDW + 2 * 31 * 256, SP_LNG = SP_BDW + 512, SP_LNB = SP_LNG + 512, SP_WSC = SP_LNB + 512, SP_BS = SP_WSC + 2 * 3 * 256, SP_GF = SP_BS + 2 * 4 * 128,
              SP_STP = SP_GF + 1024, SP_STC = SP_STP + 2 * 8 * 15 * 256, SP_STS = SP_STC + 2 * 8 * 30 * 256, SP_END = SP_STS + 2 * 8 * 2 * 256;
static_assert(WS_SMALL + (size_t)SP_END * 4 <= WS_CTL && WS_HIDS + (size_t)MS * DFF * 2 <= 64 * MiB, "ws map small");
constexpr size_t WS_XB = 64 * MiB, WS_X = 193 * MiB, WS_P = 450 * MiB, WS_MIX = 707 * MiB, WS_HID = 450 * MiB, WS_PART = 836 * MiB, WS_WDNS = 840 * MiB, WS_END = 852 * MiB;
constexpr int KH = DFF / 2;
static_assert(WS_PART + 2ull * MS * DM * 4 <= WS_WDNS && WS_WDNS + 2ull * 2 * DM * KH * 2 <= WS_END && KH % 128 == 0 && KH % 64 == 0, "split-K buffers");
static_assert(WS_XB + (size_t)MT * DM * 2 <= WS_X && WS_X + (size_t)MT * DM * 4 <= WS_P && WS_P + (size_t)MT * DIN * 2 <= WS_MIX && WS_MIX + (size_t)MT * DM * 2 <= WS_PART && WS_HID + (size_t)MT * DFF * 2 <= WS_PART, "ws map");
static_assert(WS_SSQA + (size_t)MT * 64 <= WS_SSQB && WS_SSQB + (size_t)MT * 64 <= WS_XB, "ws map ssq");
constexpr size_t O_Y = 0, O_POOLP = (size_t)MT * DM, O_POOLS = O_POOLP + 2 * 16 * 15 * 256, O_CONVP = O_POOLS + 2 * 8 * 15 * 256, O_CONVS = O_CONVP + 2 * 16 * 30 * 256,
                 O_SCP = O_CONVS + 2 * 8 * 30 * 256, O_SCS = O_SCP + 2 * 16 * 2 * 256, O_VS = O_SCS + 2 * 8 * 2 * 256, O_END = O_VS + 2 * 8 * 32 * 256;
constexpr int LDS_BYTES = 136192;
constexpr int LDS_RC = 131072 + 512;

__device__ __forceinline__ float bf_lo(unsigned u) { return __uint_as_float(u << 16); }
__device__ __forceinline__ float bf_hi(unsigned u) { return __uint_as_float(u & 0xffff0000u); }
typedef __bf16 bf16x2_t __attribute__((ext_vector_type(2)));
__device__ __forceinline__ unsigned pk_bf16(float lo, float hi) { const f32x2 v = {lo, hi}; const bf16x2_t b = __builtin_convertvector(v, bf16x2_t); return __builtin_bit_cast(unsigned, b); }
__device__ __forceinline__ float wave_sum(float v) {
#pragma unroll
    for (int o = 1; o < 64; o <<= 1) v += __shfl_xor(v, o);
    return v;
}
__device__ __forceinline__ float sigmoidf_(float x) { return 1.0f / (1.0f + __expf(-x)); }

__device__ __forceinline__ float row_rstd(const float* ssq, int row, int fq) {
    const f32x4 s = *(const f32x4*)(ssq + (size_t)row * 16 + 4 * fq);
    float t = (s[0] + s[1]) + (s[2] + s[3]);
    t += __shfl_xor(t, 16); t += __shfl_xor(t, 32);
    return rsqrtf(t * (1.0f / DM) + EPS);
}
__device__ __forceinline__ bool rc_hit(LAS float* rc, const int want, const int wave) { return __builtin_amdgcn_readfirstlane(*(volatile LAS int*)((LAS int*)(rc + 1024) + wave)) == want; }
__device__ __forceinline__ float rc_get(LAS float* rc, const bool hit, const float* ssq, const int row, const int wave, const int slot, const int fr, const int fq) {
    LAS float* e = rc + wave * 128 + slot * 16 + fr;
    if (hit) return *e;
    const float r = row_rstd(ssq, row, fq); if (fq == 0) *e = r; return r;
}
__device__ __forceinline__ void rc_commit(LAS float* rc, const bool hit, const int want, const int wave) { if (!hit) *(volatile LAS int*)((LAS int*)(rc + 1024) + wave) = want; }
struct EpiInProj {
    static constexpr bool PERM = true, AFTER_DRAIN = false;
    bf16_t* P; const float* ssq; LAS float* rc; int salt;
    __device__ __forceinline__ void operator()(const f32x4 (&acc)[2][2][4][2], const pg8::Unit& u, int wr, int wc, int fr, int fq) const {
        asm volatile("" : "+v"(fr));
        const int row0 = u.pm * 256 + wr * 64 + fr, pn = u.pn;
        const int rcw = wr * 4 + wc, rcwant = salt * 1024 + u.pm + 1; const bool rchit = rc_hit(rc, rcwant, rcw);
        const int mode = (pn == 1 || pn == 2) ? 1 : ((pn == 3 || pn == 4) ? 2 : 0);
        const int dcol = (pn == 0) ? 0 : (mode == 1 ? PC_Z + 128 * (pn - 1) : (mode == 2 ? PC_ZS + 128 * (pn - 3) : PC_B + 256 * (pn - 5)));
        const int col0 = dcol + wc * 32 + 8 * fq;
#pragma unroll
        for (int ai = 0; ai < 2; ++ai)
#pragma unroll
            for (int m = 0; m < 4; ++m) {
                const int row = row0 + ai * 128 + m * 16; const float rs = rc_get(rc, rchit, ssq, row, rcw, ai * 4 + m, fr, fq);
                bf16_t* rowp = P + (size_t)row * DP + col0;
                if (mode == 0) {
#pragma unroll
                    for (int bj = 0; bj < 2; ++bj) { const f32x4 v0 = acc[ai][bj][m][0] * rs, v1 = acc[ai][bj][m][1] * rs;
                        u32x4 w; w.x = pk_bf16(v0[0], v0[1]); w.y = pk_bf16(v0[2], v0[3]); w.z = pk_bf16(v1[0], v1[1]); w.w = pk_bf16(v1[2], v1[3]);
                        __builtin_nontemporal_store(w, (u32x4*)(rowp + bj * 128)); }
                } else {
                    float h[8];
                    const float c1 = rs * -1.4426950408889634f, rs2 = rs * rs;
#pragma unroll
                    for (int n = 0; n < 2; ++n)
#pragma unroll
                        for (int j = 0; j < 4; j += 2) { const f32x2 a = {acc[ai][0][m][n][j], acc[ai][0][m][n][j + 1]}, b = {acc[ai][1][m][n][j], acc[ai][1][m][n][j + 1]};
                            f32x2 hh;
                            if (mode == 1) { const f32x2 t = b * c1; f32x2 e; e.x = __builtin_amdgcn_exp2f(t.x); e.y = __builtin_amdgcn_exp2f(t.y);
                                const f32x2 d = e + 1.0f; f32x2 r; r.x = __builtin_amdgcn_rcpf(d.x); r.y = __builtin_amdgcn_rcpf(d.y); hh = (a * rs) * r; }
                            else hh = (a * b) * rs2;
                            h[n * 4 + j] = hh.x; h[n * 4 + j + 1] = hh.y; }
                    u32x4 w; w.x = pk_bf16(h[0], h[1]); w.y = pk_bf16(h[2], h[3]); w.z = pk_bf16(h[4], h[5]); w.w = pk_bf16(h[6], h[7]);
                    __builtin_nontemporal_store(w, (u32x4*)rowp);
                }
            }
        rc_commit(rc, rchit, rcwant, rcw);
    }
};
struct EpiSwiGLU {
    static constexpr bool PERM = true, AFTER_DRAIN = false;
    bf16_t* H; const float* ssq; LAS float* rc; int salt;
    __device__ __forceinline__ void operator()(const f32x4 (&acc)[2][2][4][2], const pg8::Unit& u, int wr, int wc, int fr, int fq) const {
        asm volatile("" : "+v"(fr));
        const int row0 = u.pm * 256 + wr * 64 + fr, col0 = u.pn * 128 + wc * 32 + 8 * fq;
        const int rcw = wr * 4 + wc, rcwant = salt * 1024 + u.pm + 1; const bool rchit = rc_hit(rc, rcwant, rcw);
#pragma unroll
        for (int ai = 0; ai < 2; ++ai)
#pragma unroll
            for (int m = 0; m < 4; ++m) {
                const int row = row0 + ai * 128 + m * 16; const float rs = rc_get(rc, rchit, ssq, row, rcw, ai * 4 + m, fr, fq);
                float h[8];
                const float c1 = rs * -1.4426950408889634f, rs2 = rs * rs;
#pragma unroll
                for (int n = 0; n < 2; ++n)
#pragma unroll
                    for (int j = 0; j < 4; j += 2) { const f32x2 ag = {acc[ai][0][m][n][j], acc[ai][0][m][n][j + 1]}, au = {acc[ai][1][m][n][j], acc[ai][1][m][n][j + 1]};
                        const f32x2 t = ag * c1; f32x2 e; e.x = __builtin_amdgcn_exp2f(t.x); e.y = __builtin_amdgcn_exp2f(t.y);
                        const f32x2 d = e + 1.0f; f32x2 r; r.x = __builtin_amdgcn_rcpf(d.x); r.y = __builtin_amdgcn_rcpf(d.y);
                        const f32x2 hh = (ag * au) * (r * rs2); h[n * 4 + j] = hh.x; h[n * 4 + j + 1] = hh.y; }
                u32x4 w; w.x = pk_bf16(h[0], h[1]); w.y = pk_bf16(h[2], h[3]); w.z = pk_bf16(h[4], h[5]); w.w = pk_bf16(h[6], h[7]);
                __builtin_nontemporal_store(w, (u32x4*)(H + (size_t)row * DFF + col0));
            }
        rc_commit(rc, rchit, rcwant, rcw);
    }
};
struct EpiResid {
    static constexpr bool PERM = false, AFTER_DRAIN = false;
    const float* rp; bf16_t* XB; float* ssq;
    __device__ __forceinline__ void operator()(const f32x4 (&acc)[2][2][4][2], const pg8::Unit& u, int wr, int wc, int fr, int fq) const {
        asm volatile("" : "+v"(fr));
        const int row0 = u.pm * 256 + wr * 64 + fr, col0 = u.pn * 256 + wc * 32 + 4 * fq;
        const bool rf32 = (rp != nullptr) && (u.pm < MP / 256);
#pragma unroll
        for (int ai = 0; ai < 2; ++ai)
#pragma unroll
            for (int m = 0; m < 4; ++m) {
                const int row = row0 + ai * 128 + m * 16; const size_t off = (size_t)row * DM + col0; float q = 0.f;
                f32x4 r4[2][2];
                if (rf32) {
#pragma unroll
                    for (int bj = 0; bj < 2; ++bj)
#pragma unroll
                        for (int n = 0; n < 2; ++n) r4[bj][n] = *(const f32x4*)(rp + off + bj * 128 + n * 16);
                } else {
#pragma unroll
                    for (int bj = 0; bj < 2; ++bj)
#pragma unroll
                        for (int n = 0; n < 2; ++n) { const u32x2 w = *(const u32x2*)(XB + off + bj * 128 + n * 16); r4[bj][n] = (f32x4){bf_lo(w.x), bf_hi(w.x), bf_lo(w.y), bf_hi(w.y)}; }
                }
#pragma unroll
                for (int bj = 0; bj < 2; ++bj)
#pragma unroll
                    for (int n = 0; n < 2; ++n) { const f32x4 x4 = r4[bj][n] + acc[ai][bj][m][n];
                        q += (x4[0] * x4[0] + x4[1] * x4[1]) + (x4[2] * x4[2] + x4[3] * x4[3]);
                        u32x2 w; w.x = pk_bf16(x4[0], x4[1]); w.y = pk_bf16(x4[2], x4[3]); *(u32x2*)(XB + off + bj * 128 + n * 16) = w; }
                q += __shfl_xor(q, 16); q += __shfl_xor(q, 32);
                if (fq == 0) ssq[(size_t)row * 16 + u.pn * 4 + wc] = q;
                if (m & 1) asm volatile("" ::: "memory");
            }
    }
};

struct Params {
    const float* x_prompt; const float* x_sample; const float* st_pool; const float* st_conv; const float* st_sc; const float* g_mix; const float* w_in; const float* w_pool;
    const float* pool_scale; const float* w_dw; const float* b_dw; const float* ln_g; const float* ln_b; const float* w_sconv; const float* w_s; const float* b_s; const float* w_out;
    const float* g_ffn; const float* w_gate; const float* w_up; const float* w_down; const float* g_final;
    float* out; unsigned char* ws;
};

__device__ __forceinline__ void transpose_item(const float* W, const float* gk, int K, int N, bf16_t* WT, int dst_row0, LAS float* scr, int k0, int n0, int lane, bf16_t* WT2 = nullptr, int K2 = 0, int k02 = 0) {
    float tv[32];
#pragma unroll
    for (int i = 0; i < 32; ++i) { const int kk = 2 * i + (lane >> 5); tv[i] = W[(size_t)(k0 + kk) * N + n0 + (lane & 31)]; }
#pragma unroll
    for (int i = 0; i < 32; ++i) { const int kk = 2 * i + (lane >> 5); float v = tv[i]; if (gk) v *= gk[k0 + kk]; scr[kk * 33 + (lane & 31)] = v; }
    asm volatile("s_waitcnt lgkmcnt(0)" ::: "memory");
    const int c = lane & 7;
#pragma unroll
    for (int j = 0; j < 4; ++j) { const int n = (lane >> 3) + 8 * j; const LAS float* s = scr + (8 * c) * 33 + n;
        u32x4 o; o.x = pk_bf16(s[0 * 33], s[1 * 33]); o.y = pk_bf16(s[2 * 33], s[3 * 33]); o.z = pk_bf16(s[4 * 33], s[5 * 33]); o.w = pk_bf16(s[6 * 33], s[7 * 33]);
        *(u32x4*)(WT + (size_t)(dst_row0 + n) * K + k0 + 8 * c) = o;
        if (WT2) *(u32x4*)(WT2 + (size_t)(dst_row0 + n) * K2 + k02 + 8 * c) = o; }
    asm volatile("s_waitcnt lgkmcnt(0)" ::: "memory");
}
__device__ __forceinline__ void prologue(const Params& p, LAS unsigned char* lds, int tid, int lane, int wave) {
    LAS float* scr = (LAS float*)(lds + wave * 16384);
    const int gw = blockIdx.x * 8 + wave, NGW = gridDim.x * 8;
    constexpr int I_IN = (DM / 64) * (DIN / 32), I_OUT = (DM / 64) * (DM / 32), I_G = (DM / 64) * (DFF / 32), I_DN = (DFF / 64) * (DM / 32);
    constexpr int I_LAYER = I_IN + I_OUT + 2 * I_G + I_DN;
    bf16_t* WIN = (bf16_t*)(p.ws + WS_WIN); bf16_t* WOUT = (bf16_t*)(p.ws + WS_WOUT); bf16_t* WGU = (bf16_t*)(p.ws + WS_WGU); bf16_t* WDN = (bf16_t*)(p.ws + WS_WDN);
    for (int it = gw; it < 2 * I_LAYER; it += NGW) {
        const int l = it / I_LAYER; int r = it % I_LAYER;
        if (r < I_IN) { const int nb = DIN / 32, k0 = 64 * (r / nb), n0 = 32 * (r % nb); const int seg = n0 >> 8, off = n0 & 255, hi = off >> 7, lo = off & 127;
            const int drow = (seg == 0) ? off : (seg == 1) ? 256 * (1 + hi) + lo : (seg == 2) ? 256 * (1 + hi) + 128 + lo : (seg == 3) ? 256 * (3 + hi) + lo : (seg == 5) ? 256 * (3 + hi) + 128 + lo : (seg == 4) ? 256 * 5 + off : 256 * seg + off;
            transpose_item(p.w_in + (size_t)l * DM * DIN, p.g_mix + l * DM, DM, DIN, WIN + (size_t)l * DIN * DM, drow, scr, k0, n0, lane); continue; } r -= I_IN;
        if (r < I_OUT) { const int nb = DM / 32, k0 = 64 * (r / nb), n0 = 32 * (r % nb); transpose_item(p.w_out + (size_t)l * DM * DM, nullptr, DM, DM, WOUT + (size_t)l * DM * DM, n0, scr, k0, n0, lane); continue; } r -= I_OUT;
        if (r < I_G) { const int nb = DFF / 32, k0 = 64 * (r / nb), n0 = 32 * (r % nb); transpose_item(p.w_gate + (size_t)l * DM * DFF, p.g_ffn + l * DM, DM, DFF, WGU + (size_t)l * NGU * DM, (n0 >> 7) * 256 + (n0 & 127), scr, k0, n0, lane); continue; } r -= I_G;
        if (r < I_G) { const int nb = DFF / 32, k0 = 64 * (r / nb), n0 = 32 * (r % nb); transpose_item(p.w_up + (size_t)l * DM * DFF, p.g_ffn + l * DM, DM, DFF, WGU + (size_t)l * NGU * DM, (n0 >> 7) * 256 + 128 + (n0 & 127), scr, k0, n0, lane); continue; } r -= I_G;
        { const int nb = DM / 32, k0 = 64 * (r / nb), n0 = 32 * (r % nb); const int kh = k0 / KH; transpose_item(p.w_down + (size_t)l * DFF * DM, nullptr, DFF, DM, WDN + (size_t)l * DM * DFF, n0, scr, k0, n0, lane, (bf16_t*)(p.ws + WS_WDNS) + (size_t)(l * 2 + kh) * DM * KH, KH, k0 - kh * KH); }
    }
    {
        bf16_t* WPT = (bf16_t*)(p.ws + WS_WPT); bf16_t* WST = (bf16_t*)(p.ws + WS_WST);
        const int gt = blockIdx.x * 512 + tid, NGT = gridDim.x * 512;
        for (int e = gt; e < 2 * 4 * 64 * 64; e += NGT) { const int c = e & 63, d = (e >> 6) & 63, lg = e >> 12;
            const float v = p.w_pool[((size_t)lg * 64 + c) * 64 + d] * p.pool_scale[(lg >> 2) * 256 + (lg & 3) * 64 + d]; WPT[e] = (bf16_t)(pk_bf16(v, 0.f) & 0xffffu); }
        for (int e = gt; e < 2 * 4 * 128 * 128; e += NGT) { const int j = e & 127, i = (e >> 7) & 127; const float v = (j <= i) ? p.w_s[e] : 0.f; WST[e] = (bf16_t)(pk_bf16(v, 0.f) & 0xffffu); }
    }
    {
        float* SP = (float*)(p.ws + WS_SMALL);
        const int gt = blockIdx.x * 512 + tid, NGT = gridDim.x * 512;
        for (int e = gt; e < SP_END; e += NGT) {
            float v;
            if (e < SP_BDW) v = p.w_dw[e - SP_WDW]; else if (e < SP_LNG) v = p.b_dw[e - SP_BDW]; else if (e < SP_LNB) v = p.ln_g[e - SP_LNG]; else if (e < SP_WSC) v = p.ln_b[e - SP_LNB];
            else if (e < SP_BS) v = p.w_sconv[e - SP_WSC]; else if (e < SP_GF) v = p.b_s[e - SP_BS]; else if (e < SP_STP) v = p.g_final[e - SP_GF]; else if (e < SP_STC) v = p.st_pool[e - SP_STP];
            else if (e < SP_STS) v = p.st_conv[e - SP_STC]; else v = p.st_sc[e - SP_STS];
            SP[e] = v;
        }
    }
}

__device__ __forceinline__ void convert_rows(const Params& p, int lane, const int gw, const int NGW, const int row_lo, const int row_hi) {
    bf16_t* XB = (bf16_t*)(p.ws + WS_XB); float* SSQ = (float*)(p.ws + WS_SSQA);
    for (int m0 = row_lo + gw; m0 < row_hi; m0 += 4 * NGW) {
        f32x4 v[4][4]; float s[4];
#pragma unroll
        for (int h = 0; h < 4; ++h) { const int m = m0 + h * NGW; const int mm = m < row_hi ? m : m0;
            const float* xrow = (mm < MP) ? p.x_prompt + (size_t)mm * DM : p.x_sample + (size_t)(mm - MP) * DM; const f32x4* xr = (const f32x4*)xrow + lane;
#pragma unroll
            for (int j = 0; j < 4; ++j) v[h][j] = xr[64 * j]; }
#pragma unroll
        for (int h = 0; h < 4; ++h) { const int m = m0 + h * NGW;
            float q = 0.f;
#pragma unroll
            for (int j = 0; j < 4; ++j) q += (v[h][j][0] * v[h][j][0] + v[h][j][1] * v[h][j][1]) + (v[h][j][2] * v[h][j][2] + v[h][j][3] * v[h][j][3]);
            s[h] = wave_sum(q);
            if (m < row_hi) { u32x2* o8 = (u32x2*)(XB + (size_t)m * DM) + lane;
#pragma unroll
                for (int j = 0; j < 4; ++j) { u32x2 w; w.x = pk_bf16(v[h][j][0], v[h][j][1]); w.y = pk_bf16(v[h][j][2], v[h][j][3]); o8[64 * j] = w; }
                if (lane < 16) SSQ[(size_t)m * 16 + lane] = (lane == 0) ? s[h] : 0.f; } }
    }
}

struct Tile { int g0, R, t0, sb, b, last; };
__device__ __forceinline__ Tile prompt_tile(int q, int R) { Tile t; t.g0 = q * R; t.R = R; t.t0 = t.g0 & (SEQ - 1); t.sb = -1; t.b = t.g0 / SEQ; t.last = (t.t0 + R == SEQ); return t; }
__device__ __forceinline__ Tile sample_tile(int b) { Tile t; t.g0 = MP + b * DSQ; t.R = DSQ; t.t0 = PAST; t.sb = b; t.b = b; t.last = 1; return t; }
__device__ __forceinline__ void unpack8(const u32x4 w, float* f) { f[0] = bf_lo(w.x); f[1] = bf_hi(w.x); f[2] = bf_lo(w.y); f[3] = bf_hi(w.y); f[4] = bf_lo(w.z); f[5] = bf_hi(w.z); f[6] = bf_lo(w.w); f[7] = bf_hi(w.w); }
__device__ __forceinline__ void store8f(float* dst, const float* f) { *(f32x4*)dst = (f32x4){f[0], f[1], f[2], f[3]}; *(f32x4*)(dst + 4) = (f32x4){f[4], f[5], f[6], f[7]}; }
__device__ __forceinline__ void load8f(const float* src, float* f) { const f32x4 a = *(const f32x4*)src, b = *(const f32x4*)(src + 4); f[0] = a[0]; f[1] = a[1]; f[2] = a[2]; f[3] = a[3]; f[4] = b[0]; f[5] = b[1]; f[6] = b[2]; f[7] = b[3]; }
#define WG_BAR() do { asm volatile("s_waitcnt lgkmcnt(0)" ::: "memory"); __builtin_amdgcn_s_barrier(); asm volatile("" ::: "memory"); } while (0)

template <int H, int K>
__device__ __forceinline__ void xstep(float (&v)[16], int lane) {
    const bool up = (lane >> K) & 1;
#pragma unroll
    for (int i = 0; i < H; ++i) { const float send = up ? v[i] : v[i + H]; const float keep = up ? v[i + H] : v[i]; v[i] = keep + __shfl_xor(send, 1 << K); }
}
__device__ __forceinline__ float xreduce16(float (&v)[16], int lane) {
    xstep<8, 0>(v, lane); xstep<4, 1>(v, lane); xstep<2, 2>(v, lane); xstep<1, 3>(v, lane);
    float r = v[0]; r += __shfl_xor(r, 16); r += __shfl_xor(r, 32); return r;
}
__device__ __forceinline__ void conv_block(const LAS float* z, LAS float* st, const float (&w)[31], float bias, int r0, int c, int lane, int wq, float (&cv)[8]) {
    float win[38];
#pragma unroll
    for (int i = 0; i < 38; ++i) win[i] = z[(r0 + i) * 256 + c];
    float sv[16];
#pragma unroll
    for (int j = 0; j < 8; ++j) { float a = bias;
#pragma unroll
        for (int k = 0; k < 31; ++k) a += w[k] * win[j + k];
        asm volatile("" : "+v"(a));
        cv[j] = a; sv[2 * j] = a; sv[2 * j + 1] = a * a; }
    const float r = xreduce16(sv, lane);
    const int idx = ((lane & 1) << 3) | ((lane & 2) << 1) | ((lane & 4) >> 1) | ((lane & 8) >> 3);
    if (lane < 16) st[((r0 + (idx >> 1)) * 4 + wq) * 2 + (idx & 1)] = r;
}
__device__ __forceinline__ void conv_norm(const LAS float* st, const float (&cv)[8], int r0, float lg, float lb, bf16_t* mixrow) {
#pragma unroll
    for (int j = 0; j < 8; ++j) { const LAS float* sp = st + (r0 + j) * 8;
        const float s = (sp[0] + sp[2]) + (sp[4] + sp[6]), q = (sp[1] + sp[3]) + (sp[5] + sp[7]);
        const float mean = s * (1.0f / 256.0f); float var = q * (1.0f / 256.0f) - mean * mean; var = var < 0.f ? 0.f : var;
        const float n = (cv[j] - mean) * rsqrtf(var + EPS) * lg + lb;
        const float y = n * __builtin_amdgcn_rcpf(1.0f + __builtin_amdgcn_exp2f(n * -1.4426950408889634f));
        mixrow[(size_t)j * DM] = (bf16_t)(pk_bf16(y, 0.f) & 0xffffu); }
}
__device__ __forceinline__ void mix_conv(const Params& p, int l, const Tile t, const bf16_t* P, bf16_t* MIX, LAS unsigned char* lds, int tid) {
    LAS float* z = (LAS float*)lds;
    LAS float* st = (LAS float*)(lds + 94 * 256 * 4);
    const float* SP = (const float*)(p.ws + WS_SMALL);
    const int lane = tid & 63, wave = tid >> 6;
    const int nitems = (t.R + 30) * 32;
    const bool hist_from_p = (t.sb < 0) && (t.t0 != 0);
    float* oconv = p.out + ((t.sb < 0) ? O_CONVP + (size_t)(l * NBP + t.b) * 30 * 256 : O_CONVS + (size_t)(l * NBS + t.b) * 30 * 256);
    {
        u32x4 A[6], G[6];
#pragma unroll
        for (int i = 0; i < 6; ++i) { const int idx = tid + 512 * i, rr = idx >> 5, c8 = (idx & 31) * 8, rrel = rr - 30;
            A[i] = (u32x4){0u, 0u, 0u, 0u}; G[i] = (u32x4){0u, 0u, 0u, 0u};
            if (idx < nitems) {
                if (rrel >= 0 || hist_from_p) A[i] = *(const u32x4*)(P + (size_t)(t.g0 + rrel) * DP + PC_Z + c8);
                else if (t.sb >= 0) { const float* sp = SP + SP_STC + ((size_t)(l * NBS + t.b) * 30 + rr) * 256 + c8; A[i] = *(const u32x4*)sp; G[i] = *(const u32x4*)(sp + 4); } } }
#pragma unroll
        for (int i = 0; i < 6; ++i) { const int idx = tid + 512 * i, rr = idx >> 5, c8 = (idx & 31) * 8, rrel = rr - 30;
            if (idx < nitems) { float zz[8];
                if (rrel >= 0 || hist_from_p) unpack8(A[i], zz);
                else { zz[0] = __uint_as_float(A[i].x); zz[1] = __uint_as_float(A[i].y); zz[2] = __uint_as_float(A[i].z); zz[3] = __uint_as_float(A[i].w);
                       zz[4] = __uint_as_float(G[i].x); zz[5] = __uint_as_float(G[i].y); zz[6] = __uint_as_float(G[i].z); zz[7] = __uint_as_float(G[i].w); }
                *(LAS f32x4*)(z + rr * 256 + c8) = (f32x4){zz[0], zz[1], zz[2], zz[3]}; *(LAS f32x4*)(z + rr * 256 + c8 + 4) = (f32x4){zz[4], zz[5], zz[6], zz[7]};
                if (t.last && rrel >= t.R - 30) store8f(oconv + (size_t)(rrel - (t.R - 30)) * 256 + c8, zz); } }
    }
    const int c = tid & 255, half = tid >> 8, rph = t.R >> 1, nblk = rph >> 3;
    float w[31];
#pragma unroll
    for (int k = 0; k < 31; ++k) w[k] = SP[SP_WDW + (l * 31 + k) * 256 + c];
    const float bias = SP[SP_BDW + l * 256 + c];
    const float lg = SP[SP_LNG + l * 256 + c], lb = SP[SP_LNB + l * 256 + c];
    WG_BAR();
    float cv[4][8];
#pragma unroll
    for (int blk = 0; blk < 4; ++blk) if (blk < nblk) conv_block(z, st, w, bias, half * rph + blk * 8, c, lane, wave & 3, cv[blk]);
    WG_BAR();
#pragma unroll
    for (int blk = 0; blk < 4; ++blk) if (blk < nblk) { const int r0 = half * rph + blk * 8; conv_norm(st, cv[blk], r0, lg, lb, MIX + (size_t)(t.g0 + r0) * DM + 256 + c); }
    WG_BAR();
}

__device__ __forceinline__ void mix_pool(const Params& p, int l, const Tile t, const bf16_t* P, bf16_t* MIX, LAS unsigned char* lds, int tid) {
    LAS float* xs = (LAS float*)lds;
    LAS bf16_t* pre = (LAS bf16_t*)(lds + 79 * 256 * 4);
    const float* SP = (const float*)(p.ws + WS_SMALL);
    const int lane = tid & 63, wave = tid >> 6;
    const int nitems = (t.R + 15) * 32;
    const bool hist_from_p = (t.sb < 0) && (t.t0 != 0);
    float* opool = p.out + ((t.sb < 0) ? O_POOLP + (size_t)(l * NBP + t.b) * 15 * 256 : O_POOLS + (size_t)(l * NBS + t.b) * 15 * 256);
    {
        u32x4 A[5], B[5];
#pragma unroll
        for (int i = 0; i < 5; ++i) { const int idx = tid + 512 * i, rr = idx >> 5, c8 = (idx & 31) * 8, rrel = rr - 15;
            A[i] = (u32x4){0u, 0u, 0u, 0u}; B[i] = (u32x4){0u, 0u, 0u, 0u};
            if (idx < nitems) {
                if (rrel >= 0 || hist_from_p) A[i] = *(const u32x4*)(P + (size_t)(t.g0 + rrel) * DP + c8);
                else if (t.sb >= 0) { const float* sp = SP + SP_STP + ((size_t)(l * NBS + t.b) * 15 + rr) * 256 + c8; A[i] = *(const u32x4*)sp; B[i] = *(const u32x4*)(sp + 4); } } }
#pragma unroll
        for (int i = 0; i < 5; ++i) { const int idx = tid + 512 * i, rr = idx >> 5, c8 = (idx & 31) * 8, rrel = rr - 15;
            if (idx < nitems) { float v[8];
                if (rrel >= 0 || hist_from_p) unpack8(A[i], v);
                else { v[0] = __uint_as_float(A[i].x); v[1] = __uint_as_float(A[i].y); v[2] = __uint_as_float(A[i].z); v[3] = __uint_as_float(A[i].w);
                       v[4] = __uint_as_float(B[i].x); v[5] = __uint_as_float(B[i].y); v[6] = __uint_as_float(B[i].z); v[7] = __uint_as_float(B[i].w); }
                *(LAS f32x4*)(xs + rr * 256 + c8) = (f32x4){v[0], v[1], v[2], v[3]}; *(LAS f32x4*)(xs + rr * 256 + c8 + 4) = (f32x4){v[4], v[5], v[6], v[7]};
                if (t.last && rrel >= t.R - 15) store8f(opool + (size_t)(rrel - (t.R - 15)) * 256 + c8, v); } }
    }
    const int g = wave >> 1, rh = wave & 1, fr = lane & 15, fq = lane >> 4, rph = t.R >> 1, mt = t.R >> 5;
    bf16x8 bf[4][2];
    {
        const bf16_t* WPT = (const bf16_t*)(p.ws + WS_WPT) + (size_t)(l * 4 + g) * 64 * 64;
#pragma unroll
        for (int n = 0; n < 4; ++n)
#pragma unroll
            for (int k = 0; k < 2; ++k) bf[n][k] = *(const bf16x8*)(WPT + (16 * n + fr) * 64 + 32 * k + 8 * fq);
    }
    WG_BAR();
    {
        const int c = tid & 255, half = tid >> 8, gg = c >> 6, w = 2 << gg;
        float mk[16];
#pragma unroll
        for (int j = 0; j < 16; ++j) mk[j] = (j < w) ? 1.0f : 0.0f;
        for (int r0 = half * rph; r0 < (half + 1) * rph; r0 += 4) {
            float v[19];
#pragma unroll
            for (int i = 0; i < 19; ++i) v[i] = xs[(r0 + i) * 256 + c];
#pragma unroll
            for (int q = 0; q < 4; ++q) { float s = 0.f;
#pragma unroll
                for (int j = 0; j < 16; ++j) s += mk[j] * v[q + 15 - j];
                const int pos = t.t0 + r0 + q; const float cnt = (float)((pos + 1 < w) ? pos + 1 : w);
                const float pv = s * __builtin_amdgcn_rcpf(cnt) - v[q + 15];
                pre[(r0 + q) * 264 + c] = (bf16_t)(pk_bf16(pv, 0.f) & 0xffffu); }
        }
    }
    WG_BAR();
#pragma unroll
    for (int m = 0; m < 2; ++m) {
        if (m < mt) {
            const int row = rh * rph + 16 * m + fr;
            bf16x8 af[2];
#pragma unroll
            for (int k = 0; k < 2; ++k) af[k] = *(const LAS bf16x8*)(pre + row * 264 + g * 64 + 32 * k + 8 * fq);
#pragma unroll
            for (int n = 0; n < 4; ++n) { f32x4 a = {0.f, 0.f, 0.f, 0.f};
#pragma unroll
                for (int k = 0; k < 2; ++k) a = __builtin_amdgcn_mfma_f32_16x16x32_bf16(bf[n][k], af[k], a, 0, 0, 0);
                u32x2 o; o.x = pk_bf16(a[0], a[1]); o.y = pk_bf16(a[2], a[3]);
                *(u32x2*)(MIX + (size_t)(t.g0 + row) * DM + g * 64 + 16 * n + 4 * fq) = o; }
        }
    }
    WG_BAR();
}

__device__ __forceinline__ void mix_sconv(const Params& p, int l, const Tile t, const bf16_t* P, bf16_t* MIX, int tid) {
    const bool hist_from_p = (t.sb < 0) && (t.t0 != 0);
    const float* SP = (const float*)(p.ws + WS_SMALL);
    float* osc = p.out + ((t.sb < 0) ? O_SCP + (size_t)(l * NBP + t.b) * 2 * 256 : O_SCS + (size_t)(l * NBS + t.b) * 2 * 256);
    const int c8 = (tid & 31) * 8, r0 = (tid >> 5) * 4;
    if (r0 >= t.R) return;
    u32x4 XS[6], CG[6], BG[4];
#pragma unroll
    for (int i = 0; i < 6; ++i) { const int rrel = r0 - 2 + i; XS[i] = (u32x4){0u, 0u, 0u, 0u}; CG[i] = (u32x4){0u, 0u, 0u, 0u};
        if (rrel >= 0 || hist_from_p) XS[i] = *(const u32x4*)(P + (size_t)(t.g0 + rrel) * DP + PC_ZS + c8);
        else if (t.sb >= 0) { const float* sp = SP + SP_STS + ((size_t)(l * NBS + t.b) * 2 + (rrel + 2)) * 256 + c8; XS[i] = *(const u32x4*)sp; CG[i] = *(const u32x4*)(sp + 4); } }
#pragma unroll
    for (int i = 0; i < 4; ++i) BG[i] = *(const u32x4*)(P + (size_t)(t.g0 + r0 + i) * DP + PC_B + c8);
    float w0[8], w1[8], w2[8];
    load8f(SP + SP_WSC + (l * 3 + 0) * 256 + c8, w0); load8f(SP + SP_WSC + (l * 3 + 1) * 256 + c8, w1); load8f(SP + SP_WSC + (l * 3 + 2) * 256 + c8, w2);
    float z[6][8];
#pragma unroll
    for (int i = 0; i < 6; ++i) { const int rrel = r0 - 2 + i;
        if (rrel >= 0 || hist_from_p) unpack8(XS[i], z[i]);
        else { z[i][0] = __uint_as_float(XS[i].x); z[i][1] = __uint_as_float(XS[i].y); z[i][2] = __uint_as_float(XS[i].z); z[i][3] = __uint_as_float(XS[i].w);
               z[i][4] = __uint_as_float(CG[i].x); z[i][5] = __uint_as_float(CG[i].y); z[i][6] = __uint_as_float(CG[i].z); z[i][7] = __uint_as_float(CG[i].w); } }
#pragma unroll
    for (int i = 0; i < 4; ++i) { const int r = r0 + i; float bg[8], o[8]; unpack8(BG[i], bg);
#pragma unroll
        for (int e = 0; e < 8; ++e) o[e] = bg[e] * (w0[e] * z[i][e] + w1[e] * z[i + 1][e] + w2[e] * z[i + 2][e]);
        u32x4 w; w.x = pk_bf16(o[0], o[1]); w.y = pk_bf16(o[2], o[3]); w.z = pk_bf16(o[4], o[5]); w.w = pk_bf16(o[6], o[7]);
        *(u32x4*)(MIX + (size_t)(t.g0 + r) * DM + 512 + c8) = w;
        if (t.last && r >= t.R - 2) store8f(osc + (size_t)(r - (t.R - 2)) * 256 + c8, z[i + 2]); }
}

template <int R>
__device__ __forceinline__ void mix_mlp(const Params& p, int l, const Tile t, const bf16_t* P, bf16_t* MIX, LAS unsigned char* lds, int tid) {
    LAS unsigned* vs32 = (LAS unsigned*)lds;
    const LAS bf16_t* vs = (const LAS bf16_t*)lds;
    const int lane = tid & 63, wave = tid >> 6;
    constexpr int NIT = R * 32 / 512;
    {
        u32x4 V[NIT];
#pragma unroll
        for (int i = 0; i < NIT; ++i) { const int idx = tid + 512 * i, r = idx >> 5, c8 = (idx & 31) * 8; V[i] = *(const u32x4*)(P + (size_t)(t.g0 + r) * DP + PC_V + c8); }
#pragma unroll
        for (int i = 0; i < NIT; ++i) { const int idx = tid + 512 * i, r = idx >> 5, c8 = (idx & 31) * 8;
            LAS unsigned* d = vs32 + r * 129 + (c8 >> 1); d[0] = V[i].x; d[1] = V[i].y; d[2] = V[i].z; d[3] = V[i].w;
            if (R == 32) { float f[8]; unpack8(V[i], f); store8f(p.out + O_VS + ((size_t)(l * NBS + t.b) * 32 + r) * 256 + c8, f); } }
    }
    const int h = wave >> 1, rh = wave & 1, fr = lane & 15, fq = lane >> 4;
    constexpr int MMAX = (R == 128) ? 4 : 2, KMAX = (R == 128) ? 4 : 1;
    const int kmax = (R == 128) ? 2 * (rh + 1) : 1;
    const bool active = (R == 128 || rh == 0);
    bf16x8 af[KMAX][MMAX]; u32x2 uu[MMAX][4]; float bias[MMAX];
    if (active) {
        const bf16_t* WST = (const bf16_t*)(p.ws + WS_WST) + (size_t)(l * 4 + h) * 128 * 128;
#pragma unroll
        for (int k = 0; k < KMAX; ++k)
#pragma unroll
            for (int m = 0; m < MMAX; ++m) af[k][m] = (k < kmax) ? *(const bf16x8*)(WST + (size_t)(64 * rh + 16 * m + fr) * 128 + 32 * k + 8 * fq) : (bf16x8){0, 0, 0, 0, 0, 0, 0, 0};
#pragma unroll
        for (int m = 0; m < MMAX; ++m) { const int i = 64 * rh + 16 * m + fr; bias[m] = ((const float*)(p.ws + WS_SMALL))[SP_BS + (l * 4 + h) * 128 + i];
#pragma unroll
            for (int n = 0; n < 4; ++n) uu[m][n] = *(const u32x2*)(P + (size_t)(t.g0 + i) * DP + PC_U + 64 * h + 16 * n + 4 * fq); }
    }
    WG_BAR();
    if (active) {
        f32x4 acc[MMAX][4];
#pragma unroll
        for (int m = 0; m < MMAX; ++m)
#pragma unroll
            for (int n = 0; n < 4; ++n) acc[m][n] = (f32x4){0.f, 0.f, 0.f, 0.f};
#pragma unroll
        for (int k = 0; k < KMAX; ++k) {
            if (k < kmax) {
                bf16x8 bf[4];
#pragma unroll
                for (int n = 0; n < 4; ++n)
#pragma unroll
                    for (int i = 0; i < 8; ++i) bf[n][i] = (short)vs[(32 * k + 8 * fq + i) * 258 + 64 * h + 16 * n + fr];
#pragma unroll
                for (int m = 0; m < MMAX; ++m)
#pragma unroll
                    for (int n = 0; n < 4; ++n) acc[m][n] = __builtin_amdgcn_mfma_f32_16x16x32_bf16(bf[n], af[k][m], acc[m][n], 0, 0, 0);
            }
        }
#pragma unroll
        for (int m = 0; m < MMAX; ++m) {
            const int i = 64 * rh + 16 * m + fr;
#pragma unroll
            for (int n = 0; n < 4; ++n) { const int d = 64 * h + 16 * n + 4 * fq;
                const float o0 = bf_lo(uu[m][n].x) * (acc[m][n][0] + bias[m]), o1 = bf_hi(uu[m][n].x) * (acc[m][n][1] + bias[m]), o2 = bf_lo(uu[m][n].y) * (acc[m][n][2] + bias[m]), o3 = bf_hi(uu[m][n].y) * (acc[m][n][3] + bias[m]);
                u32x2 o; o.x = pk_bf16(o0, o1); o.y = pk_bf16(o2, o3);
                *(u32x2*)(MIX + (size_t)(t.g0 + i) * DM + 768 + d) = o; }
        }
    }
    WG_BAR();
}


__device__ __forceinline__ void conv_loads(const Tile t, const bf16_t* P, int tid, u32x4 (&A)[6]) {
    const bool hist = (t.t0 != 0);
#pragma unroll
    for (int i = 0; i < 6; ++i) { const int idx = tid + 512 * i, rr = idx >> 5, c8 = (idx & 31) * 8, rrel = rr - 30;
        A[i] = (u32x4){0u, 0u, 0u, 0u};
        if (idx < 94 * 32 && (rrel >= 0 || hist)) A[i] = *(const u32x4*)(P + (size_t)(t.g0 + rrel) * DP + PC_Z + c8); }
}
__device__ __forceinline__ int mix_conv_run(const Params& p, int l, const bf16_t* P, bf16_t* MIX, LAS unsigned char* lds, int tid, int u, const int stride, const int uend) {
    LAS float* z = (LAS float*)lds; LAS float* st = (LAS float*)(lds + 94 * 256 * 4);
    const float* SP = (const float*)(p.ws + WS_SMALL);
    const int lane = tid & 63, wave = tid >> 6, c = tid & 255, half = tid >> 8;
    float w[31];
#pragma unroll
    for (int k = 0; k < 31; ++k) w[k] = SP[SP_WDW + (l * 31 + k) * 256 + c];
    const float bias = SP[SP_BDW + l * 256 + c], lg = SP[SP_LNG + l * 256 + c], lb = SP[SP_LNB + l * 256 + c];
    Tile t = prompt_tile(u, 64);
    u32x4 A[6]; conv_loads(t, P, tid, A);
    for (;;) {
        float* oconv = p.out + O_CONVP + (size_t)(l * NBP + t.b) * 30 * 256;
#pragma unroll
        for (int i = 0; i < 6; ++i) { const int idx = tid + 512 * i, rr = idx >> 5, c8 = (idx & 31) * 8, rrel = rr - 30;
            if (idx < 94 * 32) { float zz[8]; unpack8(A[i], zz);
                *(LAS f32x4*)(z + rr * 256 + c8) = (f32x4){zz[0], zz[1], zz[2], zz[3]}; *(LAS f32x4*)(z + rr * 256 + c8 + 4) = (f32x4){zz[4], zz[5], zz[6], zz[7]};
                if (t.last && rrel >= 34) store8f(oconv + (size_t)(rrel - 34) * 256 + c8, zz); } }
        WG_BAR();
        const int un = u + stride; const bool hn = un < uend; const Tile tn = prompt_tile(hn ? un : u, 64);
        if (hn) conv_loads(tn, P, tid, A);
        float cv[4][8];
#pragma unroll
        for (int blk = 0; blk < 4; ++blk) conv_block(z, st, w, bias, half * 32 + blk * 8, c, lane, wave & 3, cv[blk]);
        WG_BAR();
#pragma unroll
        for (int blk = 0; blk < 4; ++blk) { const int r0 = half * 32 + blk * 8; conv_norm(st, cv[blk], r0, lg, lb, MIX + (size_t)(t.g0 + r0) * DM + 256 + c); }
        WG_BAR();
        u = un; if (!hn) break; t = tn;
    }
    return u;
}
__device__ __forceinline__ void pool_loads(const Tile t, const bf16_t* P, int tid, u32x4 (&A)[5]) {
    const bool hist = (t.t0 != 0);
#pragma unroll
    for (int i = 0; i < 5; ++i) { const int idx = tid + 512 * i, rr = idx >> 5, c8 = (idx & 31) * 8, rrel = rr - 15;
        A[i] = (u32x4){0u, 0u, 0u, 0u};
        if (idx < 79 * 32 && (rrel >= 0 || hist)) A[i] = *(const u32x4*)(P + (size_t)(t.g0 + rrel) * DP + c8); }
}
__device__ __forceinline__ int mix_pool_run(const Params& p, int l, const bf16_t* P, bf16_t* MIX, LAS unsigned char* lds, int tid, int u, const int stride, const int uend) {
    LAS float* xs = (LAS float*)lds; LAS bf16_t* pre = (LAS bf16_t*)(lds + 79 * 256 * 4);
    const int lane = tid & 63, wave = tid >> 6, g = wave >> 1, rh = wave & 1, fr = lane & 15, fq = lane >> 4;
    bf16x8 bf[4][2];
    {
        const bf16_t* WPT = (const bf16_t*)(p.ws + WS_WPT) + (size_t)(l * 4 + g) * 64 * 64;
#pragma unroll
        for (int n = 0; n < 4; ++n)
#pragma unroll
            for (int k = 0; k < 2; ++k) bf[n][k] = *(const bf16x8*)(WPT + (16 * n + fr) * 64 + 32 * k + 8 * fq);
    }
    const int c = tid & 255, half = tid >> 8, gg = c >> 6, w = 2 << gg;
    float mk[16];
#pragma unroll
    for (int j = 0; j < 16; ++j) mk[j] = (j < w) ? 1.0f : 0.0f;
    Tile t = prompt_tile(u, 64);
    u32x4 A[5]; pool_loads(t, P, tid, A);
    for (;;) {
        float* opool = p.out + O_POOLP + (size_t)(l * NBP + t.b) * 15 * 256;
#pragma unroll
        for (int i = 0; i < 5; ++i) { const int idx = tid + 512 * i, rr = idx >> 5, c8 = (idx & 31) * 8, rrel = rr - 15;
            if (idx < 79 * 32) { float v[8]; unpack8(A[i], v);
                *(LAS f32x4*)(xs + rr * 256 + c8) = (f32x4){v[0], v[1], v[2], v[3]}; *(LAS f32x4*)(xs + rr * 256 + c8 + 4) = (f32x4){v[4], v[5], v[6], v[7]};
                if (t.last && rrel >= 49) store8f(opool + (size_t)(rrel - 49) * 256 + c8, v); } }
        WG_BAR();
        const int un = u + stride; const bool hn = un < uend; const Tile tn = prompt_tile(hn ? un : u, 64);
        if (hn) pool_loads(tn, P, tid, A);
        for (int r0 = half * 32; r0 < (half + 1) * 32; r0 += 4) {
            float v[19];
#pragma unroll
            for (int i = 0; i < 19; ++i) v[i] = xs[(r0 + i) * 256 + c];
#pragma unroll
            for (int q = 0; q < 4; ++q) { float sm = 0.f;
#pragma unroll
                for (int j = 0; j < 16; ++j) sm += mk[j] * v[q + 15 - j];
                const int pos = t.t0 + r0 + q; const float cnt = (float)((pos + 1 < w) ? pos + 1 : w);
                const float pv = sm * __builtin_amdgcn_rcpf(cnt) - v[q + 15];
                pre[(r0 + q) * 264 + c] = (bf16_t)(pk_bf16(pv, 0.f) & 0xffffu); }
        }
        WG_BAR();
#pragma unroll
        for (int m = 0; m < 2; ++m) {
            const int row = rh * 32 + 16 * m + fr;
            bf16x8 af[2];
#pragma unroll
            for (int k = 0; k < 2; ++k) af[k] = *(const LAS bf16x8*)(pre + row * 264 + g * 64 + 32 * k + 8 * fq);
#pragma unroll
            for (int n = 0; n < 4; ++n) { f32x4 a = {0.f, 0.f, 0.f, 0.f};
#pragma unroll
                for (int k = 0; k < 2; ++k) a = __builtin_amdgcn_mfma_f32_16x16x32_bf16(bf[n][k], af[k], a, 0, 0, 0);
                u32x2 o; o.x = pk_bf16(a[0], a[1]); o.y = pk_bf16(a[2], a[3]);
                *(u32x2*)(MIX + (size_t)(t.g0 + row) * DM + g * 64 + 16 * n + 4 * fq) = o; }
        }
        WG_BAR();
        u = un; if (!hn) break; t = tn;
    }
    return u;
}

constexpr int NU_CONV = MP / 64, NU_POOL = MP / 64, NU_MLP = MP / 128, NU_SC = MP / 64, NU_PROMPT = NU_CONV + NU_POOL + NU_MLP + NU_SC, NU_ALL = NU_PROMPT + 4 * NBS;
__device__ __forceinline__ void mixer_phase(const Params& p, int l, LAS unsigned char* lds, int tid, const int first, const int stride, const int mask = EXP_MIXMASK) {
    const bf16_t* P = (const bf16_t*)(p.ws + WS_P); bf16_t* MIX = (bf16_t*)(p.ws + WS_MIX);
    int u = first;
    asm volatile("" : "+v"(tid));
    if (u < NU_CONV) { const int un = mix_conv_run(p, l, P, MIX, lds, tid, u, stride, NU_CONV); u = un; }
    asm volatile("" : "+v"(tid));
    if (u < NU_CONV + NU_POOL) { const int un = mix_pool_run(p, l, P, MIX, lds, tid, u - NU_CONV, stride, NU_POOL); u = un + NU_CONV; }
    for (; u < NU_PROMPT; u += stride) {
        int r = u - NU_CONV - NU_POOL; asm volatile("" : "+v"(tid));
        {
            const int rn = r + stride;
            if (rn < NU_MLP) { const Tile tn = prompt_tile(rn, 128); const bf16_t* q = P + (size_t)(tn.g0 + (tid >> 2)) * DP + 64 * (tid & 3);
                (void)*(volatile const unsigned*)(q + PC_V); (void)*(volatile const unsigned*)(q + PC_U); }
            else if (rn < NU_MLP + NU_SC) { const Tile tn = prompt_tile(rn - NU_MLP, 64); const int rr = (tid >> 2) - 2;
                if (rr < 64 && (rr >= 0 || tn.t0 != 0)) (void)*(volatile const unsigned*)(P + (size_t)(tn.g0 + rr) * DP + PC_ZS + 64 * (tid & 3));
                if (rr >= 0 && rr < 64) (void)*(volatile const unsigned*)(P + (size_t)(tn.g0 + rr) * DP + PC_B + 64 * (tid & 3)); }
        }
        if (r < NU_MLP) { if (mask & 4) mix_mlp<128>(p, l, prompt_tile(r, 128), P, MIX, lds, tid); continue; } r -= NU_MLP;
        if (mask & 8) mix_sconv(p, l, prompt_tile(r, 64), P, MIX, tid);
    }
}
__device__ __forceinline__ void sample_mixers(const Params& p, int l, LAS unsigned char* lds, int tid, const int first, const int stride) {
    const bf16_t* P = (const bf16_t*)(p.ws + WS_P); bf16_t* MIX = (bf16_t*)(p.ws + WS_MIX);
    for (int r = first; r < 4 * NBS; r += stride) {
        asm volatile("" : "+v"(tid));
        const int b = r & 7, kind = r >> 3;
        if (kind == 0) mix_conv(p, l, sample_tile(b), P, MIX, lds, tid);
        else if (kind == 1) mix_pool(p, l, sample_tile(b), P, MIX, lds, tid);
        else if (kind == 2) mix_mlp<32>(p, l, sample_tile(b), P, MIX, lds, tid);
        else mix_sconv(p, l, sample_tile(b), P, MIX, tid);
    }
}

__device__ __forceinline__ void final_norm(const Params& p, int lane, int wave, const int gw, const int NGW, const int row_lo, const int row_hi) {
    const bf16_t* XB = (const bf16_t*)(p.ws + WS_XB); const float* SSQ = (const float*)(p.ws + WS_SSQA);
    f32x4 g[4];
#pragma unroll
    for (int j = 0; j < 4; ++j) g[j] = ((const f32x4*)(p.ws + WS_SMALL + (size_t)SP_GF * 4))[lane + 64 * j];
    for (int m0 = row_lo + gw; m0 < row_hi; m0 += 8 * NGW) {
        u32x2 v[8][4]; float s[8];
#pragma unroll
        for (int h = 0; h < 8; ++h) { const int m = m0 + h * NGW; const int mm = m < row_hi ? m : m0; const u32x2* xr = (const u32x2*)(XB + (size_t)mm * DM) + lane;
#pragma unroll
            for (int j = 0; j < 4; ++j) v[h][j] = xr[64 * j];
            s[h] = (lane < 16) ? SSQ[(size_t)mm * 16 + lane] : 0.f; }
#pragma unroll
        for (int h = 0; h < 8; ++h) { const int m = m0 + h * NGW; const float rs = rsqrtf(wave_sum(s[h]) * (1.0f / DM) + EPS);
            if (m < row_hi) { f32x4* o = (f32x4*)(p.out + (size_t)m * DM) + lane;
#pragma unroll
                for (int j = 0; j < 4; ++j) { const f32x4 x = {bf_lo(v[h][j].x), bf_hi(v[h][j].x), bf_lo(v[h][j].y), bf_hi(v[h][j].y)}; __builtin_nontemporal_store(x * rs * g[j], &o[64 * j]); } } }
    }
}

#define XB_TMO      128
#define XB_XCNT(j)  (256  + 64 * (j))
#define XB_XSUB(j)  (1280 + 64 * (j))
#define XB_XGEN(j)  (2304 + 64 * (j))
#define XB_TOP      3328
#define XB_TOPGEN   3392
#define XCD_BAR_WORDS 3456
#define XB_SPIN_CAP (1u << 18)

__device__ __forceinline__ unsigned xb_ld(unsigned* p)              { return __hip_atomic_load(p, __ATOMIC_RELAXED, __HIP_MEMORY_SCOPE_AGENT); }
__device__ __forceinline__ unsigned xb_add(unsigned* p, unsigned v) { return __hip_atomic_fetch_add(p, v, __ATOMIC_RELAXED, __HIP_MEMORY_SCOPE_AGENT); }
__device__ __forceinline__ unsigned xb_xcc_id() { return (unsigned)__builtin_amdgcn_s_getreg((3 << 11) | 20) & 0xFu; }
#define XB_SPIN(cond, bar) do { unsigned _sp = 0; while (cond) { __builtin_amdgcn_s_sleep(1); \
    if ((++_sp & 255u) == 0u) { if (xb_ld(&(bar)[XB_TMO])) break; if (_sp > XB_SPIN_CAP) { atomicAdd(&(bar)[XB_TMO], 1u); break; } } } } while (0)

struct XcdBarrier {
    unsigned* bar; unsigned x;
    volatile LAS unsigned* st;
};

__device__ __forceinline__ XcdBarrier xcd_barrier_post(unsigned* bar, volatile LAS unsigned* st) {
    XcdBarrier b; b.bar = bar; b.x = xb_xcc_id(); b.st = st;
    if (threadIdx.x == 0) (void)xb_add(&bar[XB_XCNT(b.x)], 1u);
    return b;
}
__device__ __forceinline__ void xcd_barrier_complete(unsigned* bar, unsigned x, unsigned& nloc, unsigned& nx) {
    const unsigned G = gridDim.x * gridDim.y * gridDim.z;
    unsigned sum, cnt, mine, sp = 0u;
    for (;;) {
        sum = 0u; cnt = 0u; mine = 0u;
#pragma unroll
        for (unsigned j = 0; j < 16; ++j) { const unsigned c = xb_ld(&bar[XB_XCNT(j)]); sum += c; cnt += (c > 0u) ? 1u : 0u; mine = (j == x) ? c : mine; }
        if (sum == G) break;
        __builtin_amdgcn_s_sleep(1);
        if ((++sp & 255u) == 0u) { if (xb_ld(&bar[XB_TMO])) break; if (sp > XB_SPIN_CAP) { atomicAdd(&bar[XB_TMO], 1u); break; } }
    }
    nloc = mine > 0u ? mine : 1u; nx = cnt > 0u ? cnt : 1u;
}

__device__ __forceinline__ void xcd_barrier(const XcdBarrier& b) {
    asm volatile("s_waitcnt vmcnt(0)" ::: "memory");
    __syncthreads();
    if (pg8::pg8_tid((LAS unsigned char*)b.st - 131072) == 0) {
        unsigned* bar = b.bar;
        __builtin_amdgcn_s_waitcnt(0);
        unsigned nloc = b.st[0], nx = b.st[1];
        if (nloc == 0u) { xcd_barrier_complete(bar, b.x, nloc, nx); b.st[0] = nloc; b.st[1] = nx; }
        const unsigned old = xb_add(&bar[XB_XSUB(b.x)], 1u);
        const unsigned gen = old / nloc;
        if (old + 1u == (gen + 1u) * nloc) {
            __builtin_amdgcn_fence(__ATOMIC_RELEASE, "agent");
            asm volatile("s_waitcnt vmcnt(0)" ::: "memory");
            const unsigned og = xb_add(&bar[XB_TOP], 1u);
            const unsigned tg = og / nx;
            if (og + 1u == (tg + 1u) * nx) xb_add(&bar[XB_TOPGEN], 1u);
            else XB_SPIN(xb_ld(&bar[XB_TOPGEN]) == tg, bar);
            __builtin_amdgcn_fence(__ATOMIC_ACQUIRE, "agent");
            xb_add(&bar[XB_XGEN(b.x)], 1u);
            asm volatile("s_waitcnt vmcnt(0)" ::: "memory");
        } else {
            XB_SPIN(xb_ld(&bar[XB_XGEN(b.x)]) == gen, bar);
            __builtin_amdgcn_fence(__ATOMIC_ACQUIRE, "agent");
            asm volatile("s_waitcnt vmcnt(0)" ::: "memory");
        }
    }
    __syncthreads();
}


constexpr int NSG = 22;
struct SampleOrder {
    int nN, c;
    __device__ __forceinline__ bool next(int i, pg8::Unit& u) const { const int j = i * NSG + c; if (j >= nN) return false; u.pm = MP / 256; u.pn = j; return true; }
    __device__ __forceinline__ void a_ready(const pg8::Unit&) const {}
    __device__ __forceinline__ void done(const pg8::Unit&) const {}
};
__device__ __forceinline__ void group_barrier(unsigned* ctr, unsigned target, unsigned* tmo, int tid) {
    asm volatile("s_waitcnt vmcnt(0)" ::: "memory");
    __syncthreads();
    if (tid == 0) {
        __builtin_amdgcn_fence(__ATOMIC_RELEASE, "agent");
        asm volatile("s_waitcnt vmcnt(0)" ::: "memory");
        (void)__hip_atomic_fetch_add(ctr, 1u, __ATOMIC_RELAXED, __HIP_MEMORY_SCOPE_AGENT);
        unsigned sp = 0;
        while (__hip_atomic_load(ctr, __ATOMIC_RELAXED, __HIP_MEMORY_SCOPE_AGENT) < target) { __builtin_amdgcn_s_sleep(1);
            if ((++sp & 255u) == 0u) { if (__hip_atomic_load(tmo, __ATOMIC_RELAXED, __HIP_MEMORY_SCOPE_AGENT)) break; if (sp > (1u << 20)) { atomicAdd(tmo, 1u); break; } } }
        __builtin_amdgcn_fence(__ATOMIC_ACQUIRE, "agent");
        asm volatile("s_waitcnt vmcnt(0)" ::: "memory");
    }
    __syncthreads();
}


struct EpiSwiGLUS {
    static constexpr bool PERM = true, AFTER_DRAIN = false;
    bf16_t* H; const float* ssq;
    __device__ __forceinline__ void operator()(const f32x4 (&acc)[2][2][4][2], const pg8::Unit& u, int wr, int wc, int fr, int fq) const {
        asm volatile("" : "+v"(fr));
        const int row0 = u.pm * 256 + wr * 64 + fr, lrow0 = wr * 64 + fr, kh = u.pn / 11, col0 = (u.pn - 11 * kh) * 128 + wc * 32 + 8 * fq;
        bf16_t* Hh = H + (size_t)kh * MS * KH;
#pragma unroll
        for (int ai = 0; ai < 2; ++ai)
#pragma unroll
            for (int m = 0; m < 4; ++m) {
                const int row = row0 + ai * 128 + m * 16; const float rs = row_rstd(ssq, row, fq);
                float h[8];
                const float c1 = rs * -1.4426950408889634f, rs2 = rs * rs;
#pragma unroll
                for (int n = 0; n < 2; ++n)
#pragma unroll
                    for (int j = 0; j < 4; j += 2) { const f32x2 ag = {acc[ai][0][m][n][j], acc[ai][0][m][n][j + 1]}, au = {acc[ai][1][m][n][j], acc[ai][1][m][n][j + 1]};
                        const f32x2 t = ag * c1; f32x2 e; e.x = __builtin_amdgcn_exp2f(t.x); e.y = __builtin_amdgcn_exp2f(t.y);
                        const f32x2 d = e + 1.0f; f32x2 r; r.x = __builtin_amdgcn_rcpf(d.x); r.y = __builtin_amdgcn_rcpf(d.y);
                        const f32x2 hh = (ag * au) * (r * rs2); h[n * 4 + j] = hh.x; h[n * 4 + j + 1] = hh.y; }
                u32x4 w; w.x = pk_bf16(h[0], h[1]); w.y = pk_bf16(h[2], h[3]); w.z = pk_bf16(h[4], h[5]); w.w = pk_bf16(h[6], h[7]);
                *(u32x4*)(Hh + (size_t)(lrow0 + ai * 128 + m * 16) * KH + col0) = w;
            }
    }
};
struct EpiPart {
    static constexpr bool PERM = false, AFTER_DRAIN = false;
    float* part;
    __device__ __forceinline__ void operator()(const f32x4 (&acc)[2][2][4][2], const pg8::Unit& u, int wr, int wc, int fr, int fq) const {
        asm volatile("" : "+v"(fr));
        const int lrow0 = wr * 64 + fr, col0 = u.pn * 256 + wc * 32 + 4 * fq;
#pragma unroll
        for (int ai = 0; ai < 2; ++ai)
#pragma unroll
            for (int m = 0; m < 4; ++m)
#pragma unroll
                for (int bj = 0; bj < 2; ++bj)
#pragma unroll
                    for (int n = 0; n < 2; ++n) *(f32x4*)(part + (size_t)(lrow0 + ai * 128 + m * 16) * DM + col0 + bj * 128 + n * 16) = acc[ai][bj][m][n];
    }
};
struct SampleOrderD {
    int c;
    __device__ __forceinline__ bool next(int i, pg8::Unit& u) const { if (i > 0 || c >= 8) return false; u.pm = 0; u.pn = c & 3; return true; }
    __device__ __forceinline__ void a_ready(const pg8::Unit&) const {}
    __device__ __forceinline__ void done(const pg8::Unit&) const {}
};
__device__ __forceinline__ void sample_combine(const Params& p, int lane, int gw, int NGW, float* ssq) {
    bf16_t* XB = (bf16_t*)(p.ws + WS_XB) + (size_t)MP * DM; const float* P0 = (const float*)(p.ws + WS_PART); const float* P1 = P0 + (size_t)MS * DM;
    for (int r = gw; r < MS; r += NGW) {
        u32x2* xr = (u32x2*)(XB + (size_t)r * DM) + lane; const f32x4* a = (const f32x4*)(P0 + (size_t)r * DM) + lane; const f32x4* b = (const f32x4*)(P1 + (size_t)r * DM) + lane;
        float q = 0.f;
#pragma unroll
        for (int j = 0; j < 4; ++j) { const u32x2 w = xr[64 * j]; const f32x4 x = (f32x4){bf_lo(w.x), bf_hi(w.x), bf_lo(w.y), bf_hi(w.y)} + a[64 * j] + b[64 * j];
            q += (x[0] * x[0] + x[1] * x[1]) + (x[2] * x[2] + x[3] * x[3]); u32x2 o; o.x = pk_bf16(x[0], x[1]); o.y = pk_bf16(x[2], x[3]); xr[64 * j] = o; }
        q = wave_sum(q);
        if (lane < 16) ssq[(size_t)(MP + r) * 16 + lane] = (lane == 0) ? q : 0.f;
    }
}


__global__ void __launch_bounds__(512, 2) fwd_megakernel(Params p) {
    extern __shared__ __attribute__((aligned(16))) unsigned char lds_raw[];
    LAS unsigned char* lds = (LAS unsigned char*)lds_raw;
    const int G = gridDim.x, bx = blockIdx.x;
#define MYTID() pg8::pg8_tid(lds)
#define LWS(name) size_t name##_z = 0; asm volatile("" : "+s"(name##_z)); unsigned char* name = p.ws + name##_z
#define SAMPLE_DOWN(L) do { \
            { LWS(ws); const int kh = (bx >> 2) & 1; \
              pg8::Gemm g{(const bf16_t*)(ws + WS_HIDS) + (size_t)kh * MS * KH, (const bf16_t*)(ws + WS_WDNS) + (size_t)((L) * 2 + kh) * DM * KH, MS, DM, KH}; SampleOrderD S{bx}; \
              EpiPart E{(float*)(ws + WS_PART) + (size_t)kh * MS * DM}; pg8::gemm_phase<EpiPart, SampleOrderD, true, true>(lds, g, S, E); } \
            { LWS(ws); group_barrier((unsigned*)(ws + WS_CTL) + 3584, NSG * (++ep), (unsigned*)(ws + WS_CTL) + 3648, MYTID()); } \
            { LWS(ws); const int t_ = MYTID(); sample_combine(p, t_ & 63, bx * 8 + (t_ >> 6), NSG * 8, (float*)(ws + WS_SSQA)); } } while (0)
#define GRID_SYNC() do { XcdBarrier b_ = bar; asm volatile("" : "+s"(b_.x)); LWS(w_); b_.bar = (unsigned*)(w_ + WS_CTL); xcd_barrier(b_); } while (0)
    { const int tid0 = threadIdx.x; volatile LAS unsigned* stw = (volatile LAS unsigned*)(lds + 131072); if (tid0 < 64) stw[tid0] = 0u;
      if (tid0 < 8) ((volatile LAS int*)(lds + LDS_RC + 4096))[tid0] = 0;
      if ((tid0 & 63) == 0) ((volatile LAS int*)(lds + 131072 + 256))[(int)__builtin_amdgcn_s_getreg((5 << 11) | 4) & 63] = tid0 >> 6; }
    __syncthreads();
    XcdBarrier bar = xcd_barrier_post((unsigned*)(p.ws + WS_CTL), (volatile LAS unsigned*)(lds + 131072));
    cg::this_grid().sync();
    { const int t_ = MYTID(); prologue(p, lds, t_, t_ & 63, t_ >> 6); convert_rows(p, t_ & 63, bx * 8 + (t_ >> 6), G * 8, MP, MT); }
    GRID_SYNC();
    constexpr int NI0 = DIN / 256;
    if (bx >= NI0) { int t_ = MYTID(); asm volatile("" : "+v"(t_)); convert_rows(p, t_ & 63, (bx - NI0) * 8 + (t_ >> 6), (G - NI0) * 8, 0, MP); }
    else { LWS(ws); pg8::Gemm g{(const bf16_t*)(ws + WS_XB), (const bf16_t*)(ws + WS_WIN), MT, DIN, DM}; SampleOrder S{DIN / 256, bx}; EpiInProj E{(bf16_t*)(ws + WS_P), (const float*)(ws + WS_SSQA), (LAS float*)(lds + LDS_RC), 9};
      pg8::gemm_phase<EpiInProj, SampleOrder, true, true>(lds, g, S, E); }
    GRID_SYNC();
#pragma unroll 1
    for (int l = 0; l < 2; ++l) {
        {
            LWS(ws);
            pg8::Gemm g{(const bf16_t*)(ws + WS_XB), (const bf16_t*)(ws + WS_WIN) + (size_t)l * DIN * DM, MP, DIN, DM}; pg8::StaticOrder S; S.init(MP, DIN, G, bx); S.wgm = 16;
            EpiInProj E{(bf16_t*)(ws + WS_P), (const float*)(ws + WS_SSQA), (LAS float*)(lds + LDS_RC), 1 + 2 * l};
            pg8::gemm_phase<EpiInProj, pg8::StaticOrder, true, true>(lds, g, S, E);
        }
        GRID_SYNC();
        if (bx >= NSG) mixer_phase(p, l, lds, MYTID(), bx - NSG, G - NSG);
        else {
            unsigned ep = 4u * (unsigned)l;
            if (l == 1) {
              { LWS(ws); pg8::Gemm g{(const bf16_t*)(ws + WS_XB), (const bf16_t*)(ws + WS_WIN) + (size_t)DIN * DM, MT, DIN, DM}; SampleOrder S{DIN / 256, bx}; EpiInProj E{(bf16_t*)(ws + WS_P), (const float*)(ws + WS_SSQA), (LAS float*)(lds + LDS_RC), 10};
                pg8::gemm_phase<EpiInProj, SampleOrder, true, true>(lds, g, S, E); }
              { LWS(ws); group_barrier((unsigned*)(ws + WS_CTL) + 3584, NSG * (++ep), (unsigned*)(ws + WS_CTL) + 3648, MYTID()); }
            }
            sample_mixers(p, l, lds, MYTID(), bx, NSG);
            { LWS(ws); group_barrier((unsigned*)(ws + WS_CTL) + 3584, NSG * (++ep), (unsigned*)(ws + WS_CTL) + 3648, MYTID()); }
            { LWS(ws); pg8::Gemm g{(const bf16_t*)(ws + WS_MIX), (const bf16_t*)(ws + WS_WOUT) + (size_t)l * DM * DM, MT, DM, DM}; SampleOrder S{DM / 256, bx};
              EpiResid E{nullptr, (bf16_t*)(ws + WS_XB), (float*)(ws + WS_SSQB)}; pg8::gemm_phase<EpiResid, SampleOrder, true, true>(lds, g, S, E); }
            { LWS(ws); group_barrier((unsigned*)(ws + WS_CTL) + 3584, NSG * (++ep), (unsigned*)(ws + WS_CTL) + 3648, MYTID()); }
            { LWS(ws); pg8::Gemm g{(const bf16_t*)(ws + WS_XB), (const bf16_t*)(ws + WS_WGU) + (size_t)l * NGU * DM, MT, NGU, DM}; SampleOrder S{NGU / 256, bx};
              EpiSwiGLUS E{(bf16_t*)(ws + WS_HIDS), (const float*)(ws + WS_SSQB)}; pg8::gemm_phase<EpiSwiGLUS, SampleOrder, true, true>(lds, g, S, E); }
            if (l == 0) {
                { LWS(ws); group_barrier((unsigned*)(ws + WS_CTL) + 3584, NSG * (++ep), (unsigned*)(ws + WS_CTL) + 3648, MYTID()); }
                SAMPLE_DOWN(0);
            }
        }
        GRID_SYNC();
        {
            LWS(ws);
            pg8::Gemm g{(const bf16_t*)(ws + WS_MIX), (const bf16_t*)(ws + WS_WOUT) + (size_t)l * DM * DM, MP, DM, DM}; pg8::StaticOrder S; S.init(MP, DM, G, bx);
            EpiResid E{nullptr, (bf16_t*)(ws + WS_XB), (float*)(ws + WS_SSQB)};
            pg8::gemm_phase<EpiResid, pg8::StaticOrder, true, true>(lds, g, S, E);
        }
        GRID_SYNC();
        {
            LWS(ws);
            pg8::Gemm g{(const bf16_t*)(ws + WS_XB), (const bf16_t*)(ws + WS_WGU) + (size_t)l * NGU * DM, MP, NGU, DM}; pg8::StaticOrder S; S.init(MP, NGU, G, bx);
            EpiSwiGLU E{(bf16_t*)(ws + WS_HID), (const float*)(ws + WS_SSQB), (LAS float*)(lds + LDS_RC), 2 + 2 * l};
            pg8::gemm_phase<EpiSwiGLU, pg8::StaticOrder, true, true>(lds, g, S, E);
        }
        GRID_SYNC();
        {
            LWS(ws);
            pg8::Gemm g{(const bf16_t*)(ws + WS_HID), (const bf16_t*)(ws + WS_WDN) + (size_t)l * DM * DFF, MP, DM, DFF}; pg8::StaticOrder S; S.init(MP, DM, G, bx);
            EpiResid E{nullptr, (bf16_t*)(ws + WS_XB), (float*)(ws + WS_SSQA)};
            pg8::gemm_phase<EpiResid, pg8::StaticOrder, true, true>(lds, g, S, E);
        }
        GRID_SYNC();
    }
    if (bx >= NSG) { int t2 = MYTID(); asm volatile("" : "+v"(t2)); final_norm(p, t2 & 63, t2 >> 6, (bx - NSG) * 8 + (t2 >> 6), (G - NSG) * 8, 0, MP); }
    else {
        unsigned ep = 7u;
        SAMPLE_DOWN(1);
        { LWS(ws); group_barrier((unsigned*)(ws + WS_CTL) + 3584, NSG * (++ep), (unsigned*)(ws + WS_CTL) + 3648, MYTID()); }
        { int t2 = MYTID(); asm volatile("" : "+v"(t2)); final_norm(p, t2 & 63, t2 >> 6, bx * 8 + (t2 >> 6), NSG * 8, MP, MT); }
    }
}

extern "C" void kernel_launch(void* const* d_in, const int* in_sizes, int n_in, void* d_out, int out_size, void* d_ws, size_t ws_size, hipStream_t stream) {
    static int grid = 0;
    if (grid == 0) {
        if ((size_t)out_size != O_END) fprintf(stderr, "kernel_launch: note: out_size %d, expected %zu\n", out_size, (size_t)O_END);
        if (n_in != 22 || in_sizes[0] != MP * DM || ws_size < WS_END) {
            fprintf(stderr, "kernel_launch: unexpected shapes: n_in %d in0 %d out %d ws %zu (need %zu)\n", n_in, n_in > 0 ? in_sizes[0] : -1, out_size, ws_size, (size_t)WS_END); grid = -1; return; }
        int dev = 0, cus = 0, per_cu = 0;
        (void)hipGetDevice(&dev); (void)hipDeviceGetAttribute(&cus, hipDeviceAttributeMultiprocessorCount, dev);
        if (hipFuncSetAttribute((const void*)fwd_megakernel, hipFuncAttributeMaxDynamicSharedMemorySize, LDS_BYTES) != hipSuccess) { fprintf(stderr, "kernel_launch: hipFuncSetAttribute failed\n"); grid = -1; return; }
        if (hipOccupancyMaxActiveBlocksPerMultiprocessor(&per_cu, (const void*)fwd_megakernel, 512, LDS_BYTES) != hipSuccess || per_cu < 1) { fprintf(stderr, "kernel_launch: occupancy query says %d blocks per CU\n", per_cu); per_cu = 1; }
        (void)hipGetLastError();
        grid = cus * per_cu;
    }
    if (grid < 0) return;
    if (hipMemsetAsync((char*)d_ws + WS_CTL, 0, CTL_BYTES, stream) != hipSuccess) { fprintf(stderr, "kernel_launch: memset failed\n"); return; }
    Params p{};
    const float** pp = (const float**)&p;
    for (int i = 0; i < 22; ++i) pp[i] = (const float*)d_in[i];
    p.out = (float*)d_out; p.ws = (unsigned char*)d_ws;
    void* args[] = {&p};
    hipError_t e = hipLaunchCooperativeKernel((const void*)fwd_megakernel, dim3(grid), dim3(512), args, LDS_BYTES, stream);
    if (e != hipSuccess) fprintf(stderr, "kernel_launch: cooperative launch failed: %s (grid %d)\n", hipGetErrorString(e), grid);
}
```
